# Optimizing an MI355X kernel written in HIP

```python
import jax, jax.numpy as jnp
from jax import lax
import numpy as np

D_MODEL = 1024
BATCH = 2
SEQ = 8192
DEPTH = 4

HEAD_DIM = 64
NORM_EPS = 1e-6
GM_HEADS = 4
GM_WIDTH = GM_HEADS * HEAD_DIM
GM_CHUNK = 128
GLA_HEADS = 4
GLA_DV = HEAD_DIM
GLA_DK = HEAD_DIM // 2
GLA_WIDTH = GLA_HEADS * GLA_DV
GLA_KEY_WIDTH = GLA_HEADS * GLA_DK
GLA_GATE_RANK = 16
GLA_TAU = 16.0
GLA_CHUNK = 16
SWA_Q_HEADS = 8
SWA_KV_HEADS = 2
SWA_GROUP = SWA_Q_HEADS // SWA_KV_HEADS
SWA_WIDTH = SWA_Q_HEADS * HEAD_DIM
SWA_KV_WIDTH = SWA_KV_HEADS * HEAD_DIM
SWA_WINDOW = 128
SWA_BLOCK = 128
ROPE_THETA = 10000.0
D_MIX = GM_WIDTH + GLA_WIDTH + SWA_WIDTH
IN_SPLITS = (GM_WIDTH, GM_WIDTH, GM_WIDTH,
             GLA_KEY_WIDTH, GLA_KEY_WIDTH, GLA_WIDTH,
             GLA_GATE_RANK, GLA_WIDTH,
             SWA_WIDTH, SWA_KV_WIDTH, SWA_KV_WIDTH, SWA_WIDTH)
D_IN = 3 * GM_WIDTH + 2 * GLA_KEY_WIDTH + 2 * GLA_WIDTH + GLA_GATE_RANK + 2 * SWA_WIDTH + 2 * SWA_KV_WIDTH

kernel_name = "hybrid_sgu_gla_swa_sink_block"


def rms_norm(x, g):
    xf = x.astype(jnp.float32)
    y = xf * lax.rsqrt(jnp.mean(xf * xf, axis=-1, keepdims=True) + NORM_EPS)
    return (y * g.astype(jnp.float32)).astype(x.dtype)


def layer_norm(x, g, b):
    xf = x.astype(jnp.float32)
    mu = jnp.mean(xf, axis=-1, keepdims=True)
    xc = xf - mu
    y = xc * lax.rsqrt(jnp.mean(xc * xc, axis=-1, keepdims=True) + NORM_EPS)
    return (y * g.astype(jnp.float32) + b.astype(jnp.float32)).astype(x.dtype)


def rope(x, positions):
    d = x.shape[-1]
    half = d // 2
    inv_freq = jnp.power(ROPE_THETA, -jnp.arange(half, dtype=jnp.float32) * 2.0 / d)
    ang = positions.astype(jnp.float32)[..., None] * inv_freq
    cos = jnp.cos(ang)[:, :, None, :]
    sin = jnp.sin(ang)[:, :, None, :]
    xf = x.astype(jnp.float32)
    x1, x2 = xf[..., :half], xf[..., half:]
    return jnp.concatenate([x1 * cos - x2 * sin, x2 * cos + x1 * sin], axis=-1).astype(x.dtype)


def spatial_gating(u, v, ln_g, ln_b, ws, bs):
    b, s, _ = u.shape
    nc = s // GM_CHUNK
    v = layer_norm(v, ln_g, ln_b)
    vc = v.reshape(b, nc, GM_CHUNK, GM_HEADS, HEAD_DIM)
    causal = jnp.tril(jnp.ones((GM_CHUNK, GM_CHUNK), dtype=bool))
    w = jnp.where(causal[None], ws, 0.0).astype(vc.dtype)
    sv = jnp.einsum('htc,bnchd->bnthd', w, vc) + bs.T.astype(vc.dtype)[:, :, None]
    return u * sv.reshape(b, s, GM_WIDTH)


def gated_linear_attention(q, k, v, g_low, wg2, bg, norm_g):
    b, s, _ = q.shape
    nc, L = s // GLA_CHUNK, GLA_CHUNK
    f32 = jnp.float32
    q = q.astype(f32).reshape(b, nc, L, GLA_HEADS, GLA_DK) * (GLA_DK ** -0.5)
    k = k.astype(f32).reshape(b, nc, L, GLA_HEADS, GLA_DK)
    v = v.astype(f32).reshape(b, nc, L, GLA_HEADS, GLA_DV)
    logit = jnp.einsum('bsr,rc->bsc', g_low.astype(f32), wg2.astype(f32)) + bg.astype(f32)
    log_a = jax.nn.log_sigmoid(logit) / GLA_TAU
    G = jnp.cumsum(log_a.reshape(b, nc, L, GLA_HEADS, GLA_DK), axis=2)
    causal = jnp.tril(jnp.ones((L, L), dtype=bool))[:, :, None, None]
    diff = G[:, :, :, None] - G[:, :, None, :]
    decay = jnp.where(causal, jnp.exp(jnp.where(causal, diff, 0.0)), 0.0)
    attn = jnp.einsum('bnthk,bnshk,bntshk->bnhts', q, k, decay)
    o_intra = jnp.einsum('bnhts,bnshv->bnthv', attn, v)
    G_last = G[:, :, -1]
    k_dec = k * jnp.exp(G_last[:, :, None] - G)
    U = jnp.einsum('bnshk,bnshv->bnhkv', k_dec, v)
    chunk_decay = jnp.exp(G_last)

    def step(state, inp):
        a, u_n = inp
        return a[..., None] * state + u_n, state

    s0 = jnp.zeros((b, GLA_HEADS, GLA_DK, GLA_DV), f32)
    _, s_prev = lax.scan(step, s0, (jnp.moveaxis(chunk_decay, 1, 0), jnp.moveaxis(U, 1, 0)))
    s_prev = jnp.moveaxis(s_prev, 0, 1)
    o_inter = jnp.einsum('bnthk,bnhkv->bnthv', q * jnp.exp(G), s_prev)
    o = (o_intra + o_inter).reshape(b, s, GLA_HEADS, GLA_DV)
    o = rms_norm(o, norm_g)
    return o.reshape(b, s, GLA_WIDTH)


def sliding_window_attention(q, k, v, sinks, positions):
    b, s, _ = q.shape
    T = SWA_BLOCK
    nb = s // T
    q = rope(q.reshape(b, s, SWA_Q_HEADS, HEAD_DIM), positions)
    k = rope(k.reshape(b, s, SWA_KV_HEADS, HEAD_DIM), positions)
    v = v.reshape(b, s, SWA_KV_HEADS, HEAD_DIM)
    qb = q.reshape(b, nb, T, SWA_KV_HEADS, SWA_GROUP, HEAD_DIM)

    def band(t):
        tp = jnp.pad(t, ((0, 0), (T, 0), (0, 0), (0, 0))).reshape(b, nb + 1, T, SWA_KV_HEADS, HEAD_DIM)
        return jnp.concatenate([tp[:, :-1], tp[:, 1:]], axis=2)

    kb, vb = band(k), band(v)
    scores = jnp.einsum('bnqhgd,bnkhd->bnhgqk', qb, kb).astype(jnp.float32) * (HEAD_DIM ** -0.5)
    qpos = jnp.arange(nb)[:, None] * T + jnp.arange(T)[None, :]
    kpos = (jnp.arange(nb)[:, None] - 1) * T + jnp.arange(2 * T)[None, :]
    rel = qpos[:, :, None] - kpos[:, None, :]
    mask = (rel >= 0) & (rel < SWA_WINDOW) & (kpos[:, None, :] >= 0)
    scores = jnp.where(mask[None, :, None, None], scores, -jnp.inf)
    sink = jnp.broadcast_to(sinks.astype(jnp.float32).reshape(1, 1, SWA_KV_HEADS, SWA_GROUP, 1, 1),
                            scores.shape[:-1] + (1,))
    probs = jax.nn.softmax(jnp.concatenate([scores, sink], axis=-1), axis=-1)[..., :-1]
    out = jnp.einsum('bnhgqk,bnkhd->bnqhgd', probs.astype(vb.dtype), vb)
    return out.reshape(b, s, SWA_WIDTH)


def hybrid_layer(x, positions, pre_g, w_in, gm_ln_g, gm_ln_b, gm_ws, gm_bs,
                 gla_wg2, gla_bg, gla_norm_g, swa_sinks, w_out, post_g):
    h = rms_norm(x, pre_g)
    proj = jnp.einsum('bsd,dc->bsc', h, w_in)
    split_points = np.cumsum(IN_SPLITS)[:-1].tolist()
    (gm_u, gm_v, gm_z, gla_q, gla_k, gla_v, gla_glr, gla_z,
     swa_q, swa_k, swa_v, swa_z) = jnp.split(proj, split_points, axis=-1)
    y_a = spatial_gating(gm_u, gm_v, gm_ln_g, gm_ln_b, gm_ws, gm_bs) * jax.nn.silu(gm_z)
    y_b = gated_linear_attention(gla_q, gla_k, gla_v, gla_glr, gla_wg2, gla_bg,
                                 gla_norm_g).astype(x.dtype) * jax.nn.silu(gla_z)
    y_c = sliding_window_attention(swa_q, swa_k, swa_v, swa_sinks, positions) * jax.nn.silu(swa_z)
    y = jnp.einsum('bsc,cd->bsd', jnp.concatenate([y_a, y_b, y_c], axis=-1), w_out)
    return x + rms_norm(y, post_g)


def setup_inputs(seed: int = 0) -> dict:
    key = jax.random.key(seed)
    ks = jax.random.split(key, 16)
    f32 = jnp.float32
    x = jax.random.normal(ks[0], (BATCH, SEQ, D_MODEL), f32)
    positions = jnp.broadcast_to(jnp.arange(SEQ, dtype=jnp.int32)[None, :], (BATCH, SEQ))
    pre_g = 1.0 + 0.1 * jax.random.normal(ks[1], (DEPTH, D_MODEL), f32)
    w_in = jax.random.normal(ks[2], (DEPTH, D_MODEL, D_IN), f32) * (D_MODEL ** -0.5)
    gm_ln_g = 1.0 + 0.1 * jax.random.normal(ks[3], (DEPTH, GM_WIDTH), f32)
    gm_ln_b = 0.02 * jax.random.normal(ks[4], (DEPTH, GM_WIDTH), f32)
    gm_ws = jax.random.normal(ks[5], (DEPTH, GM_HEADS, GM_CHUNK, GM_CHUNK), f32) * (GM_CHUNK ** -0.5)
    gm_bs = 1.0 + 0.1 * jax.random.normal(ks[6], (DEPTH, GM_HEADS, GM_CHUNK), f32)
    gla_wg2 = jax.random.normal(ks[7], (DEPTH, GLA_GATE_RANK, GLA_KEY_WIDTH), f32) * (GLA_GATE_RANK ** -0.5)
    gla_bg = 0.1 * jax.random.normal(ks[8], (DEPTH, GLA_KEY_WIDTH), f32)
    gla_norm_g = 1.0 + 0.1 * jax.random.normal(ks[9], (DEPTH, GLA_DV), f32)
    swa_sinks = 0.5 * jax.random.normal(ks[10], (DEPTH, SWA_Q_HEADS), f32)
    w_out = jax.random.normal(ks[11], (DEPTH, D_MIX, D_MODEL), f32) * (D_MIX ** -0.5)
    post_g = 1.0 + 0.1 * jax.random.normal(ks[12], (DEPTH, D_MODEL), f32)
    return {"x": x, "positions": positions, "pre_g": pre_g, "w_in": w_in,
            "gm_ln_g": gm_ln_g, "gm_ln_b": gm_ln_b, "gm_ws": gm_ws, "gm_bs": gm_bs,
            "gla_wg2": gla_wg2, "gla_bg": gla_bg, "gla_norm_g": gla_norm_g,
            "swa_sinks": swa_sinks, "w_out": w_out, "post_g": post_g}


def reference(x, positions, pre_g, w_in, gm_ln_g, gm_ln_b, gm_ws, gm_bs,
              gla_wg2, gla_bg, gla_norm_g, swa_sinks, w_out, post_g):
    h = x
    for l in range(DEPTH):
        h = hybrid_layer(h, positions, pre_g[l], w_in[l], gm_ln_g[l], gm_ln_b[l], gm_ws[l], gm_bs[l],
                         gla_wg2[l], gla_bg[l], gla_norm_g[l], swa_sinks[l], w_out[l], post_g[l])
    return h
```

```cpp
#include <hip/hip_runtime.h>
#include <cstdio>
#include <cstdint>
#define MK_ONE_LAUNCH 1
namespace pg8 {
#define PG8_LAS __attribute__((address_space(3)))
typedef unsigned short bf16_t;
typedef short bf16x8 __attribute__((ext_vector_type(8)));
typedef float f32x4 __attribute__((ext_vector_type(4)));
typedef unsigned u32x4 __attribute__((ext_vector_type(4)));
constexpr int BM = 256, BK = 64, HALF = 128, HTB = HALF * BK * 2  , STAGE_BYTES = 8 * HTB, NXCD = 8, WGM = 8;

__host__ __device__ __forceinline__ int lds_byte(int r, int c) { const int st = (r >> 4) * 2 + (c >> 5), rr = r & 15, cc = c & 31, ob = rr * 64 + cc * 2; return st * 1024 + (ob ^ (((ob >> 9) & 1) << 5)); }
__host__ __device__ __forceinline__ void stage_rc(int b, int& R, int& C) { const int st = b / 1024, sb = b % 1024, swz = sb ^ (((sb >> 9) & 1) << 5); R = (st >> 1) * 16 + swz / 64; C = (st & 1) * 32 + (swz % 64) / 2; }
__host__ __device__ __forceinline__ int perm32(int rho) { const int n = rho >> 4, i = rho & 15; return 8 * (i >> 2) + 4 * n + (i & 3); }

struct Unit { int pm, pn; };
struct Gemm { const bf16_t* A; const bf16_t* Bt; int M, N, K; };

struct StaticOrder {
    int nM, nN, nwg, G, c;
    __host__ __device__ void init(int M, int N, int G_, int c_) { nM = M / BM; nN = N / BM; nwg = nM * nN; G = G_; c = c_; }
    __host__ __device__ bool next(int i, Unit& u) const {
        const long L = (long)i * G + c; if (L >= nwg) return false;
        int wgid = (int)L; { const int q = nwg / NXCD, r = nwg % NXCD, xcd = wgid % NXCD, off = wgid / NXCD; wgid = (xcd < r ? xcd * (q + 1) : r * (q + 1) + (xcd - r) * q) + off; }
        const int nig = WGM * nN, gid = wgid / nig, fm = gid * WGM, gsz = (nM - fm) < WGM ? (nM - fm) : WGM;
        u.pm = fm + ((wgid % nig) % gsz); u.pn = (wgid % nig) / gsz; return true;
    }
    __device__ __forceinline__ void a_ready(const Unit&) const {}
    __device__ __forceinline__ void done(const Unit&) const {}
};


__device__ __forceinline__ unsigned cvt_pk_bf16(float lo, float hi) { unsigned r; asm volatile("v_cvt_pk_bf16_f32 %0, %1, %2" : "=v"(r) : "v"(lo), "v"(hi)); return r; }

struct EpiProj {
    static constexpr bool PERM = true, AFTER_DRAIN = false;
    bf16_t* O; int ldc; const float* rstd;
    __device__ __forceinline__ void operator()(const f32x4 (&acc)[2][2][4][2], const Unit& u, int wr, int wc, int fr, int fq) const {
        const int row0 = u.pm * BM + wr * 64 + fr, col0 = u.pn * BM + wc * 32 + 8 * fq;
#pragma unroll
        for (int ai = 0; ai < 2; ++ai)
#pragma unroll
            for (int m = 0; m < 4; ++m) { const int row = row0 + ai * HALF + m * 16; const float sc = rstd[row]; bf16_t* rowp = O + (size_t)row * ldc + col0;
#pragma unroll
                for (int bj = 0; bj < 2; ++bj) { const f32x4 v0 = acc[ai][bj][m][0] * sc, v1 = acc[ai][bj][m][1] * sc;
                    u32x4 w; w.x = cvt_pk_bf16(v0[0], v0[1]); w.y = cvt_pk_bf16(v0[2], v0[3]); w.z = cvt_pk_bf16(v1[0], v1[1]); w.w = cvt_pk_bf16(v1[2], v1[3]);
                    *(u32x4*)(rowp + bj * HALF) = w; } }
    }
};
struct EpiY {
    static constexpr bool PERM = false, AFTER_DRAIN = false;
    float* Y; int ldc; float* ssq;
    __device__ __forceinline__ void operator()(const f32x4 (&acc)[2][2][4][2], const Unit& u, int wr, int wc, int fr, int fq) const {
        const int row0 = u.pm * BM + wr * 64 + fr, col0 = u.pn * BM + wc * 32 + 4 * fq;
#pragma unroll
        for (int ai = 0; ai < 2; ++ai)
#pragma unroll
            for (int m = 0; m < 4; ++m) { const int row = row0 + ai * HALF + m * 16; float* rowp = Y + (size_t)row * ldc + col0; float s = 0.f;
#pragma unroll
                for (int bj = 0; bj < 2; ++bj)
#pragma unroll
                    for (int n = 0; n < 2; ++n) { const f32x4 v = acc[ai][bj][m][n]; s += (v[0] * v[0] + v[1] * v[1]) + (v[2] * v[2] + v[3] * v[3]); *(f32x4*)(rowp + bj * HALF + n * 16) = v; }
                s += __shfl_xor(s, 16); s += __shfl_xor(s, 32);
                if (fq == 0) ssq[(size_t)row * 16 + u.pn * 4 + wc] = s; }
    }
};
template <class Epi, class Sched, bool ALIGN_EPI = false, bool SP2 = false>
__device__ __forceinline__ void gemm_phase(PG8_LAS unsigned char* lds, const Gemm g, const Sched& S, const Epi& E) {
    const int tid = threadIdx.x, wid = __builtin_amdgcn_readfirstlane(tid >> 6), lane = tid & 63, wr = wid >> 2, wc = wid & 3, fr = lane & 15, fq = lane >> 4;
    const int K = g.K, nt = K / BK;
    unsigned voffA[2], voffB[2];
#pragma unroll
    for (int i = 0; i < 2; ++i) { int R, C; stage_rc(tid * 16 + i * 8192, R, C); const int Rb = Epi::PERM ? ((R & ~31) + perm32(R & 31)) : R;
        voffA[i] = (unsigned)(R * K + C) * 2u; voffB[i] = (unsigned)(Rb * K + C) * 2u; }
    const size_t kstep = (size_t)(BK * 2);
    const size_t hstep = (size_t)HALF * K * 2;
    const size_t tstep = 2 * hstep;
    const unsigned ldsw = (unsigned)wid * 1024u;
    const int aoff = lds_byte(wr * 64 + fr, fq * 8), boff = lds_byte(wc * 32 + fr, fq * 8);
#define PG8_SA(b, h) (((b) * 2 + (h)) * HTB)
#define PG8_SB(b, h) ((4 + (b) * 2 + (h)) * HTB)
#define PG8_STAGE(bufoff, gbase, voff) do { _Pragma("unroll") for (int _i = 0; _i < 2; ++_i) \
        __builtin_amdgcn_global_load_lds((const unsigned*)((const char*)(gbase) + (voff)[_i]), (PG8_LAS unsigned*)(lds + (bufoff) + ldsw + _i * 8192), 16, 0, 0); } while (0)
#define PG8_LDA(dst, b, h) do { _Pragma("unroll") for (int m = 0; m < 4; ++m) _Pragma("unroll") for (int k = 0; k < 2; ++k) dst[m][k] = *(const PG8_LAS bf16x8*)(lds + PG8_SA(b, h) + aoff + m * 2048 + k * 1024); } while (0)
#define PG8_LDB(dst, b, h) do { _Pragma("unroll") for (int n = 0; n < 2; ++n) _Pragma("unroll") for (int k = 0; k < 2; ++k) dst[n][k] = *(const PG8_LAS bf16x8*)(lds + PG8_SB(b, h) + boff + n * 2048 + k * 1024); } while (0)
#define PG8_MMA(ai, bj, At, Bt) do { __builtin_amdgcn_s_setprio(1); _Pragma("unroll") for (int m = 0; m < 4; ++m) _Pragma("unroll") for (int n = 0; n < 2; ++n) _Pragma("unroll") for (int k = 0; k < 2; ++k) \
        acc[ai][bj][m][n] = __builtin_amdgcn_mfma_f32_16x16x32_bf16(Bt[n][k], At[m][k], acc[ai][bj][m][n], 0, 0, 0); __builtin_amdgcn_s_setprio(0); } while (0)
#define PG8_WAIT_V(n) asm volatile("s_waitcnt vmcnt(" #n ")" ::: "memory")
#define PG8_WAIT_L(n) asm volatile("s_waitcnt lgkmcnt(" #n ")" ::: "memory")
#define PG8_BAR __builtin_amdgcn_s_barrier()
#define PG8_SCHED __builtin_amdgcn_sched_barrier(0)
    Unit cur, nxt; int ui = 0;
    if (!S.next(0, cur)) return;
    f32x4 acc[2][2][4][2];
#pragma unroll
    for (int a = 0; a < 2; ++a)
#pragma unroll
        for (int b = 0; b < 2; ++b)
#pragma unroll
            for (int m = 0; m < 4; ++m)
#pragma unroll
                for (int n = 0; n < 2; ++n) acc[a][b][m][n] = (f32x4){0.f, 0.f, 0.f, 0.f};
    bf16x8 At[4][2], B0[2][2], B1[2][2];
    const char* cA = (const char*)g.A + (size_t)cur.pm * tstep; const char* cB = (const char*)g.Bt + (size_t)cur.pn * tstep;
    S.a_ready(cur);
    if constexpr (SP2) {
        PG8_STAGE(PG8_SB(0, 0), cB, voffB); PG8_STAGE(PG8_SB(0, 1), cB + hstep, voffB); PG8_STAGE(PG8_SA(0, 0), cA, voffA); PG8_STAGE(PG8_SA(0, 1), cA + hstep, voffA);
        if (wr == 1) PG8_BAR;
        PG8_WAIT_V(2); PG8_BAR;
        PG8_STAGE(PG8_SB(1, 0), cB + kstep, voffB); PG8_STAGE(PG8_SA(1, 0), cA + kstep, voffA); PG8_STAGE(PG8_SB(1, 1), cB + hstep + kstep, voffB);
        PG8_WAIT_V(6); PG8_BAR;
    } else {
        PG8_STAGE(PG8_SB(0, 0), cB, voffB); PG8_STAGE(PG8_SA(0, 0), cA, voffA); PG8_STAGE(PG8_SB(0, 1), cB + hstep, voffB); PG8_STAGE(PG8_SA(0, 1), cA + hstep, voffA);
        if (wr == 1) PG8_BAR;
        PG8_WAIT_V(4); PG8_BAR;
        PG8_STAGE(PG8_SB(1, 0), cB + kstep, voffB); PG8_STAGE(PG8_SA(1, 0), cA + kstep, voffA); PG8_STAGE(PG8_SB(1, 1), cB + hstep + kstep, voffB);
        PG8_WAIT_V(6); PG8_BAR;
    }
    for (;;) {
        const bool has_next = S.next(ui + 1, nxt);
        const char* nA = has_next ? (const char*)g.A + (size_t)nxt.pm * tstep : cA; const char* nB = has_next ? (const char*)g.Bt + (size_t)nxt.pn * tstep : cB;
        for (int t = 0; t < nt; t += 2) {
            const bool last = (t == nt - 2);
            const char* a1 = cA + (size_t)(t + 1) * kstep;
            const char* a2 = last ? nA : cA + (size_t)(t + 2) * kstep; const char* b2 = last ? nB : cB + (size_t)(t + 2) * kstep;
            const char* a3 = a2 + kstep; const char* b3 = b2 + kstep;
            if (last && has_next) S.a_ready(nxt);
            if constexpr (SP2) {
            PG8_LDB(B0, 0, 0); PG8_LDB(B1, 0, 1); PG8_SCHED; PG8_LDA(At, 0, 0); PG8_STAGE(PG8_SA(1, 1), a1 + hstep, voffA);
            PG8_WAIT_V(8); PG8_WAIT_L(0); PG8_BAR; PG8_MMA(0, 0, At, B0); PG8_MMA(0, 1, At, B1); PG8_BAR; PG8_SCHED;
            PG8_LDA(At, 0, 1); PG8_STAGE(PG8_SB(0, 0), b2, voffB); PG8_STAGE(PG8_SB(0, 1), b2 + hstep, voffB); PG8_STAGE(PG8_SA(0, 0), a2, voffA);
            PG8_WAIT_V(8); PG8_WAIT_L(0); PG8_BAR; PG8_MMA(1, 0, At, B0); PG8_MMA(1, 1, At, B1); PG8_BAR; PG8_SCHED;
            PG8_LDB(B0, 1, 0); PG8_LDB(B1, 1, 1); PG8_SCHED; PG8_LDA(At, 1, 0); PG8_STAGE(PG8_SA(0, 1), a2 + hstep, voffA);
            PG8_WAIT_V(8); PG8_WAIT_L(0); PG8_BAR; PG8_MMA(0, 0, At, B0); PG8_MMA(0, 1, At, B1); PG8_BAR; PG8_SCHED;
            PG8_LDA(At, 1, 1); PG8_STAGE(PG8_SB(1, 0), b3, voffB); PG8_STAGE(PG8_SB(1, 1), b3 + hstep, voffB); PG8_STAGE(PG8_SA(1, 0), a3, voffA);
            PG8_WAIT_V(8); PG8_WAIT_L(0); PG8_BAR; PG8_MMA(1, 0, At, B0); PG8_MMA(1, 1, At, B1); PG8_BAR; PG8_SCHED;
            } else {
            PG8_LDB(B0, 0, 0); PG8_SCHED; PG8_LDA(At, 0, 0); PG8_STAGE(PG8_SA(1, 1), a1 + hstep, voffA);
            PG8_WAIT_L(8); PG8_BAR; PG8_WAIT_L(0); PG8_MMA(0, 0, At, B0); PG8_BAR; PG8_SCHED;
            PG8_LDB(B1, 0, 1); PG8_STAGE(PG8_SB(0, 0), b2, voffB);
            PG8_BAR; PG8_WAIT_L(0); PG8_MMA(0, 1, At, B1); PG8_BAR;
            PG8_LDA(At, 0, 1); PG8_STAGE(PG8_SA(0, 0), a2, voffA);
            PG8_BAR; PG8_WAIT_L(0); PG8_MMA(1, 0, At, B0); PG8_BAR; PG8_SCHED;
            PG8_STAGE(PG8_SB(0, 1), b2 + hstep, voffB);
            PG8_WAIT_V(6); PG8_BAR; PG8_MMA(1, 1, At, B1); PG8_BAR;
            PG8_LDB(B0, 1, 0); PG8_SCHED; PG8_LDA(At, 1, 0); PG8_STAGE(PG8_SA(0, 1), a2 + hstep, voffA);
            PG8_WAIT_L(8); PG8_BAR; PG8_WAIT_L(0); PG8_MMA(0, 0, At, B0); PG8_BAR; PG8_SCHED;
            PG8_LDB(B1, 1, 1); PG8_STAGE(PG8_SB(1, 0), b3, voffB);
            PG8_BAR; PG8_WAIT_L(0); PG8_MMA(0, 1, At, B1); PG8_BAR;
            PG8_LDA(At, 1, 1); PG8_STAGE(PG8_SA(1, 0), a3, voffA);
            PG8_BAR; PG8_WAIT_L(0); PG8_MMA(1, 0, At, B0); PG8_BAR; PG8_SCHED;
            PG8_STAGE(PG8_SB(1, 1), b3 + hstep, voffB);
            PG8_WAIT_V(6); PG8_BAR; PG8_MMA(1, 1, At, B1); PG8_BAR;
            }
        }
        if constexpr (ALIGN_EPI) { if (wr == 0) PG8_BAR; }
        if constexpr (!Epi::AFTER_DRAIN) { E(acc, cur, wr, wc, fr, fq); S.done(cur); }
        if (!has_next) break;
#pragma unroll
        for (int a = 0; a < 2; ++a)
#pragma unroll
            for (int b = 0; b < 2; ++b)
#pragma unroll
                for (int m = 0; m < 4; ++m)
#pragma unroll
                    for (int n = 0; n < 2; ++n) acc[a][b][m][n] = (f32x4){0.f, 0.f, 0.f, 0.f};
        cur = nxt; cA = nA; cB = nB; ++ui;
        if constexpr (ALIGN_EPI) { if (wr == 1) PG8_BAR; }
    }
    PG8_WAIT_V(0);
    if constexpr (!ALIGN_EPI) { if (wr == 0) PG8_BAR; }
    PG8_BAR;
    if constexpr (Epi::AFTER_DRAIN) { E.fused(acc, cur, wr, wc, fr, fq, lds, wid, lane); S.done(cur); }
#undef PG8_SA
#undef PG8_SB
#undef PG8_STAGE
#undef PG8_LDA
#undef PG8_LDB
#undef PG8_MMA
#undef PG8_WAIT_V
#undef PG8_WAIT_L
#undef PG8_BAR
#undef PG8_SCHED
}
}

constexpr int NWAVES = 8;
#ifndef MK_ONE_LAUNCH
#define MK_ONE_LAUNCH 1
#endif

constexpr int BATCH = 2, SEQ = 8192, D = 1024, DEPTH = 4, M = BATCH * SEQ;
constexpr int D_IN = 2832, NP = 3072;
constexpr int C_GMU = 0, C_GMV = 256, C_GMZ = 512, C_GQ = 768, C_GK = 896, C_GV = 1024, C_GLG = 1280, C_GZ = 1408, C_SQ = 1664, C_SK = 2176, C_SV = 2304, C_SZ = 2432, C_END = 2944;
constexpr int S_GLR = 1280;
constexpr float EPS = 1e-6f;
constexpr int PH_PER_LAYER = 5, N_PHASES = 1 + DEPTH * PH_PER_LAYER;

constexpr size_t MiB = 1u << 20;
constexpr size_t WS_CTL = 0, CTL_ZERO_BYTES = 1 * MiB;
constexpr size_t WS_WIN = 2 * MiB;
constexpr size_t WS_WOUT = 26 * MiB;
constexpr size_t WS_ROPE = 34 * MiB;
constexpr size_t WS_SSQP = 38 * MiB;
constexpr size_t WS_RSTD = 39 * MiB;
constexpr size_t WS_GLAU = 40 * MiB;
constexpr size_t WS_GLAA = 44 * MiB;
constexpr size_t WS_XB = 48 * MiB;
constexpr size_t WS_YMIX = 80 * MiB;
constexpr size_t WS_PROJ = 112 * MiB;
constexpr size_t WS_Y = WS_PROJ;
constexpr size_t WS_END = 208 * MiB;
constexpr int CW_BAR = 4096;

constexpr int LDS_BYTES = 163840;
constexpr int LDSCTL_OFF = LDS_BYTES - 1024, MISC_OFF = LDSCTL_OFF + 320;

#define GAS __attribute__((address_space(1)))
#define LAS __attribute__((address_space(3)))
typedef unsigned short bf16;
typedef unsigned v4u __attribute__((ext_vector_type(4)));
typedef float f32x4 __attribute__((ext_vector_type(4)));
typedef short bf16x8 __attribute__((ext_vector_type(8)));
typedef GAS unsigned gu32;
typedef GAS unsigned long long gu64;
#define RLX_AGENT __ATOMIC_RELAXED, __HIP_MEMORY_SCOPE_AGENT
#define LDS_WAIT() asm volatile("s_waitcnt lgkmcnt(0)" ::: "memory")
#define VM_WAIT() asm volatile("s_waitcnt vmcnt(0)" ::: "memory")
__device__ __forceinline__ unsigned long long rt() { return __builtin_amdgcn_s_memrealtime(); }
__device__ __forceinline__ unsigned f2bf(float f) { unsigned u = __builtin_bit_cast(unsigned, f); return (u + 0x7fffu + ((u >> 16) & 1u)) >> 16; }
__device__ __forceinline__ unsigned pk2(float lo, float hi) { return f2bf(lo) | (f2bf(hi) << 16); }

#define XB_TMO      128
#define XB_XCNT(j)  (256  + 64 * (j))
#define XB_XSUB(j)  (1280 + 64 * (j))
#define XB_XGEN(j)  (2304 + 64 * (j))
#define XB_TOP      3328
#define XB_TOPGEN   3392
#define XCD_BAR_WORDS 3456
#define XB_SPIN_CAP (1u << 18)

__device__ __forceinline__ unsigned xb_ld(unsigned* p)              { return __hip_atomic_load(p, __ATOMIC_RELAXED, __HIP_MEMORY_SCOPE_AGENT); }
__device__ __forceinline__ unsigned xb_add(unsigned* p, unsigned v) { return __hip_atomic_fetch_add(p, v, __ATOMIC_RELAXED, __HIP_MEMORY_SCOPE_AGENT); }
__device__ __forceinline__ unsigned xb_xcc_id() { return (unsigned)__builtin_amdgcn_s_getreg((3 << 11) | 20) & 0xFu; }
#define XB_SPIN(cond, bar) do { unsigned _sp = 0; while (cond) { __builtin_amdgcn_s_sleep(1); \
    if ((++_sp & 255u) == 0u) { if (xb_ld(&(bar)[XB_TMO])) break; if (_sp > XB_SPIN_CAP) { atomicAdd(&(bar)[XB_TMO], 1u); break; } } } } while (0)

struct XcdBarrier {
    unsigned* bar; unsigned x;
    volatile LAS unsigned* st;
};

__device__ __forceinline__ XcdBarrier xcd_barrier_post(unsigned* bar, volatile LAS unsigned* st) {
    XcdBarrier b; b.bar = bar; b.x = xb_xcc_id(); b.st = st;
    if (threadIdx.x == 0) (void)xb_add(&bar[XB_XCNT(b.x)], 1u);
    return b;
}
__device__ __forceinline__ void xcd_barrier_complete(unsigned* bar, unsigned x, unsigned& nloc, unsigned& nx) {
    const unsigned G = gridDim.x * gridDim.y * gridDim.z;
    unsigned sum, cnt, mine, sp = 0u;
    for (;;) {
        sum = 0u; cnt = 0u; mine = 0u;
#pragma unroll
        for (unsigned j = 0; j < 16; ++j) { const unsigned c = xb_ld(&bar[XB_XCNT(j)]); sum += c; cnt += (c > 0u) ? 1u : 0u; mine = (j == x) ? c : mine; }
        if (sum == G) break;
        __builtin_amdgcn_s_sleep(1);
        if ((++sp & 255u) == 0u) { if (xb_ld(&bar[XB_TMO])) break; if (sp > XB_SPIN_CAP) { atomicAdd(&bar[XB_TMO], 1u); break; } }
    }
    nloc = mine > 0u ? mine : 1u; nx = cnt > 0u ? cnt : 1u;
}

__device__ __forceinline__ void xcd_barrier(const XcdBarrier& b) {
    asm volatile("s_waitcnt vmcnt(0)" ::: "memory");
    __syncthreads();
    if (threadIdx.x == 0) {
        unsigned* bar = b.bar;
        __builtin_amdgcn_s_waitcnt(0);
        unsigned nloc = b.st[0], nx = b.st[1];
        if (nloc == 0u) { xcd_barrier_complete(bar, b.x, nloc, nx); b.st[0] = nloc; b.st[1] = nx; }
        const unsigned old = xb_add(&bar[XB_XSUB(b.x)], 1u);
        const unsigned gen = old / nloc;
        if (old + 1u == (gen + 1u) * nloc) {
            __builtin_amdgcn_fence(__ATOMIC_RELEASE, "agent");
            asm volatile("s_waitcnt vmcnt(0)" ::: "memory");
            const unsigned og = xb_add(&bar[XB_TOP], 1u);
            const unsigned tg = og / nx;
            if (og + 1u == (tg + 1u) * nx) xb_add(&bar[XB_TOPGEN], 1u);
            else XB_SPIN(xb_ld(&bar[XB_TOPGEN]) == tg, bar);
            __builtin_amdgcn_fence(__ATOMIC_ACQUIRE, "agent");
            xb_add(&bar[XB_XGEN(b.x)], 1u);
            asm volatile("s_waitcnt vmcnt(0)" ::: "memory");
        } else {
            XB_SPIN(xb_ld(&bar[XB_XGEN(b.x)]) == gen, bar);
            __builtin_amdgcn_fence(__ATOMIC_ACQUIRE, "agent");
            asm volatile("s_waitcnt vmcnt(0)" ::: "memory");
        }
    }
    __syncthreads();
}

typedef float f32x2 __attribute__((ext_vector_type(2)));
#define KIN(i) (((const void* const volatile __attribute__((address_space(4)))*)__builtin_amdgcn_kernarg_segment_ptr())[i])
struct Frame {
    LAS unsigned char* lds;
    float* ldsf;
    volatile LAS unsigned* MISC;
    int tid, lane, wave;
    int vcu, G;
    __device__ __forceinline__ float* outp() const { return (float*)KIN(14); }
    __device__ __forceinline__ unsigned char* wsp() const { return (unsigned char*)KIN(15); }
    __device__ __forceinline__ gu32* ctl() const { return (gu32*)(wsp() + WS_CTL); }
    __device__ __forceinline__ const float* x() const { return (const float*)KIN(0); }
    __device__ __forceinline__ const int* positions() const { return (const int*)KIN(1); }
    __device__ __forceinline__ const float* pre_g() const { return (const float*)KIN(2); }
    __device__ __forceinline__ const float* w_in() const { return (const float*)KIN(3); }
    __device__ __forceinline__ const float* gm_ln_g() const { return (const float*)KIN(4); }
    __device__ __forceinline__ const float* gm_ln_b() const { return (const float*)KIN(5); }
    __device__ __forceinline__ const float* gm_ws() const { return (const float*)KIN(6); }
    __device__ __forceinline__ const float* gm_bs() const { return (const float*)KIN(7); }
    __device__ __forceinline__ const float* gla_wg2() const { return (const float*)KIN(8); }
    __device__ __forceinline__ const float* gla_bg() const { return (const float*)KIN(9); }
    __device__ __forceinline__ const float* gla_norm_g() const { return (const float*)KIN(10); }
    __device__ __forceinline__ const float* swa_sinks() const { return (const float*)KIN(11); }
    __device__ __forceinline__ const float* w_out() const { return (const float*)KIN(12); }
    __device__ __forceinline__ const float* post_g() const { return (const float*)KIN(13); }
    __device__ __forceinline__ bf16* Win_t() const { return (bf16*)(wsp() + WS_WIN); }
    __device__ __forceinline__ bf16* Wout_t() const { return (bf16*)(wsp() + WS_WOUT); }
    __device__ __forceinline__ bf16* XB() const { return (bf16*)(wsp() + WS_XB); }
    __device__ __forceinline__ bf16* YMIX() const { return (bf16*)(wsp() + WS_YMIX); }
    __device__ __forceinline__ bf16* PROJ() const { return (bf16*)(wsp() + WS_PROJ); }
    __device__ __forceinline__ f32x2* ROPE() const { return (f32x2*)(wsp() + WS_ROPE); }
    __device__ __forceinline__ float* SSQP() const { return (float*)(wsp() + WS_SSQP); }
    __device__ __forceinline__ float* RSTD() const { return (float*)(wsp() + WS_RSTD); }
    __device__ __forceinline__ float* GLAU() const { return (float*)(wsp() + WS_GLAU); }
    __device__ __forceinline__ float* GLAA() const { return (float*)(wsp() + WS_GLAA); }
    __device__ __forceinline__ float* Y() const { return (float*)(wsp() + WS_Y); }
};
__device__ __forceinline__ float bf2f(unsigned short u) { return __uint_as_float((unsigned)u << 16); }
__device__ __forceinline__ float bflo(unsigned u) { return __uint_as_float(u << 16); }
__device__ __forceinline__ float bfhi(unsigned u) { return __uint_as_float(u & 0xffff0000u); }
__device__ __forceinline__ float silu_f(float x) { return x / (1.f + __expf(-x)); }
__device__ __forceinline__ float wave_sum(float v) {
#pragma unroll
    for (int o = 1; o < 64; o <<= 1) v += __shfl_xor(v, o);
    return v;
}

__device__ __forceinline__ void p0_win_item(Frame& F, int l, int kb, int nb, LAS float* scr) {
    const int lane = F.lane, k0 = 64 * kb, n0 = 32 * nb, c = lane & 7;
    bf16* WT = F.Win_t() + (size_t)l * NP * D;
    if (nb >= C_END / 32) {
#pragma unroll
        for (int j = 0; j < 4; ++j) { const int n = (lane >> 3) + 8 * j; *(GAS v4u*)(WT + (size_t)(n0 + n) * D + k0 + 8 * c) = (v4u){0u, 0u, 0u, 0u}; }
        return;
    }
    const float* W = F.w_in() + (size_t)l * D * D_IN; const float* g = F.pre_g() + l * D;
    const int n = lane & 31;
    if (nb >= C_GLG / 32 && nb < C_GZ / 32) {
        const float* wg2 = F.gla_wg2() + l * 16 * 128 + (n0 - C_GLG + n);
        float w2[16];
#pragma unroll
        for (int r = 0; r < 16; ++r) w2[r] = wg2[r * 128];
#pragma unroll 4
        for (int i = 0; i < 32; ++i) { const int kk = 2 * i + (lane >> 5); const float* wr = W + (size_t)(k0 + kk) * D_IN + S_GLR; float a = 0.f;
#pragma unroll
            for (int r = 0; r < 16; ++r) a += wr[r] * w2[r];
            scr[kk * 33 + n] = a * g[k0 + kk]; }
    } else {
        const int sn0 = (nb < C_GLG / 32) ? n0 : n0 - 112;
#pragma unroll 8
        for (int i = 0; i < 32; ++i) { const int kk = 2 * i + (lane >> 5); scr[kk * 33 + n] = W[(size_t)(k0 + kk) * D_IN + sn0 + n] * g[k0 + kk]; }
    }
    LDS_WAIT(); asm volatile("" ::: "memory");
#pragma unroll
    for (int j = 0; j < 4; ++j) { const int nn = (lane >> 3) + 8 * j; const LAS float* s = scr + (8 * c) * 33 + nn;
        v4u o; o.x = pk2(s[0 * 33], s[1 * 33]); o.y = pk2(s[2 * 33], s[3 * 33]); o.z = pk2(s[4 * 33], s[5 * 33]); o.w = pk2(s[6 * 33], s[7 * 33]);
        *(GAS v4u*)(WT + (size_t)(n0 + nn) * D + k0 + 8 * c) = o; }
    LDS_WAIT(); asm volatile("" ::: "memory");
}
__device__ __forceinline__ void p0_transpose_item(const float* W, int K, int N, bf16* WT, LAS float* scr, int item, int lane) {
    const int nblk = N / 32, kb = item / nblk, nb = item % nblk, k0 = 64 * kb, n0 = 32 * nb;
#pragma unroll 8
    for (int i = 0; i < 32; ++i) { const int kk = 2 * i + (lane >> 5); scr[kk * 33 + (lane & 31)] = W[(size_t)(k0 + kk) * N + n0 + (lane & 31)]; }
    LDS_WAIT(); asm volatile("" ::: "memory");
    const int c = lane & 7;
#pragma unroll
    for (int j = 0; j < 4; ++j) { const int n = (lane >> 3) + 8 * j; const LAS float* s = scr + (8 * c) * 33 + n;
        v4u o; o.x = pk2(s[0 * 33], s[1 * 33]); o.y = pk2(s[2 * 33], s[3 * 33]); o.z = pk2(s[4 * 33], s[5 * 33]); o.w = pk2(s[6 * 33], s[7 * 33]);
        *(GAS v4u*)(WT + (size_t)(n0 + n) * K + k0 + 8 * c) = o; }
    LDS_WAIT(); asm volatile("" ::: "memory");
}
__device__ __forceinline__ void p0_prologue(Frame& F) {
    { int t_ = threadIdx.x; asm volatile("" : "+v"(t_)); F.tid = t_; F.lane = t_ & 63; F.wave = __builtin_amdgcn_readfirstlane(t_ >> 6); }
    LAS float* scr = (LAS float*)(F.lds + F.wave * 16384);
    const int gw = F.vcu * NWAVES + F.wave, NGW = F.G * NWAVES;
    constexpr int I_IN = (D / 64) * (NP / 32), I_OUT = (D / 64) * (D / 32);
    for (int it = gw; it < DEPTH * (I_IN + I_OUT); it += NGW) {
        if (it < DEPTH * I_IN) { const int l = it / I_IN, r = it % I_IN; p0_win_item(F, l, r / (NP / 32), r % (NP / 32), scr); }
        else { const int r2 = it - DEPTH * I_IN, l = r2 / I_OUT, r = r2 % I_OUT; p0_transpose_item(F.w_out() + (size_t)l * D * D, D, D, F.Wout_t() + (size_t)l * D * D, scr, r, F.lane); }
    }
    for (int m = gw; m < M; m += NGW) {
        const GAS f32x4* xr = (const GAS f32x4*)(F.x() + (size_t)m * D) + F.lane;
        f32x4 v[4]; float s = 0.f;
#pragma unroll
        for (int j = 0; j < 4; ++j) { v[j] = xr[64 * j]; s += (v[j].x * v[j].x + v[j].y * v[j].y) + (v[j].z * v[j].z + v[j].w * v[j].w); }
        s = wave_sum(s);
        if (F.lane == 0) F.RSTD()[m] = 1.f / sqrtf(s * (1.f / D) + EPS);
        GAS unsigned long long* o8 = (GAS unsigned long long*)(F.XB() + (size_t)m * D) + F.lane;
#pragma unroll
        for (int j = 0; j < 4; ++j) o8[64 * j] = (unsigned long long)pk2(v[j].x, v[j].y) | ((unsigned long long)pk2(v[j].z, v[j].w) << 32);
    }
    {
        const int i = F.lane & 31; const float inv = powf(10000.0f, -(float)i * 2.0f / 64.0f);
        for (int t = gw * 2; t < M; t += NGW * 2) { const int tok = t + (F.lane >> 5); const float ang = (float)F.positions()[tok] * inv; float sn, cs; sincosf(ang, &sn, &cs); F.ROPE()[(size_t)tok * 32 + i] = (f32x2){cs, sn}; }
    }
}

__device__ __forceinline__ void sgu_naive(Frame& F, int l) {
    { int t_ = threadIdx.x; asm volatile("" : "+v"(t_)); F.tid = t_; F.lane = t_ & 63; F.wave = __builtin_amdgcn_readfirstlane(t_ >> 6); }
    float* Vn = F.ldsf;
    const float* lng = F.gm_ln_g() + l * 256; const float* lnb = F.gm_ln_b() + l * 256;
    const float* ws = F.gm_ws() + (size_t)l * 4 * 128 * 128; const float* bs = F.gm_bs() + l * 4 * 128;
    for (int u = blockIdx.x; u < 512; u += F.G) {
        const int c = u >> 2, h = u & 3, r0 = c * 128;
        for (int i = 0; i < 16; ++i) { const int t = F.wave * 16 + i; const bf16* p = F.PROJ() + (size_t)(r0 + t) * NP + C_GMV + F.lane * 4;
            const uint2 raw = *(const uint2*)p; const float v0 = bflo(raw.x), v1 = bfhi(raw.x), v2 = bflo(raw.y), v3 = bfhi(raw.y);
            const float mean = wave_sum((v0 + v1) + (v2 + v3)) * (1.f / 256.f);
            const float d0 = v0 - mean, d1 = v1 - mean, d2 = v2 - mean, d3 = v3 - mean;
            const float var = wave_sum((d0 * d0 + d1 * d1) + (d2 * d2 + d3 * d3)) * (1.f / 256.f);
            const float rs = 1.f / sqrtf(var + EPS);
            if ((F.lane >> 4) == h) { const int cc = F.lane * 4, dd = cc - h * 64; float* o = Vn + t * 64 + dd;
                o[0] = d0 * rs * lng[cc] + lnb[cc]; o[1] = d1 * rs * lng[cc + 1] + lnb[cc + 1]; o[2] = d2 * rs * lng[cc + 2] + lnb[cc + 2]; o[3] = d3 * rs * lng[cc + 3] + lnb[cc + 3]; }
        }
        __syncthreads();
        const int d = F.tid & 63, tg = F.wave;
        for (int i = 0; i < 16; ++i) { const int t = tg + 8 * i; const float* wrow = ws + ((size_t)h * 128 + t) * 128; float a = 0.f;
            for (int c2 = 0; c2 <= t; ++c2) a += wrow[c2] * Vn[c2 * 64 + d];
            const float sv = a + bs[h * 128 + t];
            const bf16* pr = F.PROJ() + (size_t)(r0 + t) * NP; const float uu = bf2f(pr[C_GMU + h * 64 + d]), zz = bf2f(pr[C_GMZ + h * 64 + d]);
            F.YMIX()[(size_t)(r0 + t) * D + h * 64 + d] = (bf16)f2bf(uu * sv * silu_f(zz)); }
        __syncthreads();
    }
}
constexpr int GL_G = 0, GL_K = 128 * 33, GL_Q = 2 * 128 * 33, GL_V = 3 * 128 * 33, GL_S = GL_V + 128 * 64, GL_SCR = GL_S + 32 * 64;
__device__ __forceinline__ void gla_load(Frame& F, int l, int seq, int blk, bool want_q) {
    float* Gs = F.ldsf + GL_G; float* Ks = F.ldsf + GL_K; float* Qs = F.ldsf + GL_Q; float* Vs = F.ldsf + GL_V;
    const int b = seq >> 2, h = seq & 3, r0 = b * SEQ + blk * 128;
    const float* bg = F.gla_bg() + l * 128 + h * 32;
    { const int k = F.tid & 31, tq = F.tid >> 5;
        for (int i = 0; i < 8; ++i) { const int t = tq + 16 * i; const bf16* pr = F.PROJ() + (size_t)(r0 + t) * NP;
            const float xl = bf2f(pr[C_GLG + h * 32 + k]) + bg[k];
            const float ls = fminf(xl, 0.f) - log1pf(expf(-fabsf(xl)));
            Gs[t * 33 + k] = ls * (1.f / 16.f);
            Ks[t * 33 + k] = bf2f(pr[C_GK + h * 32 + k]);
            if (want_q) Qs[t * 33 + k] = bf2f(pr[C_GQ + h * 32 + k]) * 0.17677669529663687f; } }
    { const int v = F.tid & 63, tg = F.tid >> 6;
        for (int i = 0; i < 16; ++i) { const int t = tg + 8 * i; Vs[t * 64 + v] = bf2f(F.PROJ()[(size_t)(r0 + t) * NP + C_GV + h * 64 + v]); } }
    __syncthreads();
    if (F.tid < 32) { float run = 0.f; for (int t = 0; t < 128; ++t) { run += Gs[t * 33 + F.tid]; Gs[t * 33 + F.tid] = run; } }
    __syncthreads();
}
__device__ __forceinline__ void gla_summ_naive(Frame& F, int l) {
    { int t_ = threadIdx.x; asm volatile("" : "+v"(t_)); F.tid = t_; F.lane = t_ & 63; F.wave = __builtin_amdgcn_readfirstlane(t_ >> 6); }
    float* Gs = F.ldsf + GL_G; float* Ks = F.ldsf + GL_K; float* Vs = F.ldsf + GL_V;
    for (int u = blockIdx.x; u < 512; u += F.G) {
        const int seq = u >> 6, blk = u & 63;
        gla_load(F, l, seq, blk, false);
        const int v = F.tid & 63, kq = F.wave;
        float acc[4] = {0.f, 0.f, 0.f, 0.f}, ge[4];
#pragma unroll
        for (int j = 0; j < 4; ++j) ge[j] = Gs[127 * 33 + kq + 8 * j];
        for (int s = 0; s < 128; ++s) { const float vv = Vs[s * 64 + v];
#pragma unroll
            for (int j = 0; j < 4; ++j) { const int k = kq + 8 * j; acc[j] += Ks[s * 33 + k] * __expf(ge[j] - Gs[s * 33 + k]) * vv; } }
        float* U = F.GLAU() + (size_t)(seq * 64 + blk) * 2048;
#pragma unroll
        for (int j = 0; j < 4; ++j) U[(kq + 8 * j) * 64 + v] = acc[j];
        if (F.tid < 32) F.GLAA()[(seq * 64 + blk) * 32 + F.tid] = __expf(Gs[127 * 33 + F.tid]);
        __syncthreads();
    }
}
__device__ __forceinline__ void gla_out_naive(Frame& F, int l) {
    { int t_ = threadIdx.x; asm volatile("" : "+v"(t_)); F.tid = t_; F.lane = t_ & 63; F.wave = __builtin_amdgcn_readfirstlane(t_ >> 6); }
    float* Gs = F.ldsf + GL_G; float* Ks = F.ldsf + GL_K; float* Qs = F.ldsf + GL_Q; float* Vs = F.ldsf + GL_V; float* Sin = F.ldsf + GL_S; float* scw = F.ldsf + GL_SCR + F.wave * 128;
    const float* ng = F.gla_norm_g() + l * 64;
    for (int u = blockIdx.x; u < 512; u += F.G) {
        const int seq = u >> 6, blk = u & 63, b = seq >> 2, h = seq & 3, r0 = b * SEQ + blk * 128;
        { float s[4] = {0.f, 0.f, 0.f, 0.f}; const float* Ub = F.GLAU() + (size_t)seq * 64 * 2048; const float* Ab = F.GLAA() + seq * 64 * 32;
            for (int i = 0; i < blk; ++i) {
#pragma unroll
                for (int j = 0; j < 4; ++j) { const int e = F.tid + 512 * j; s[j] = Ab[i * 32 + (e >> 6)] * s[j] + Ub[(size_t)i * 2048 + e]; } }
#pragma unroll
            for (int j = 0; j < 4; ++j) Sin[F.tid + 512 * j] = s[j]; }
        gla_load(F, l, seq, blk, true);
        const int v = F.lane, w = F.wave;
        for (int i = 0; i < 16; ++i) { const int t = w + 8 * i;
#pragma unroll
            for (int half = 0; half < 2; ++half) { const int s_ = F.lane + 64 * half; float a = 0.f;
                if (s_ <= t) { for (int k = 0; k < 32; ++k) a += Qs[t * 33 + k] * Ks[s_ * 33 + k] * __expf(Gs[t * 33 + k] - Gs[s_ * 33 + k]); }
                scw[s_] = a; }
            float o = 0.f;
            for (int s_ = 0; s_ <= t; ++s_) o += scw[s_] * Vs[s_ * 64 + v];
            for (int k = 0; k < 32; ++k) o += Qs[t * 33 + k] * __expf(Gs[t * 33 + k]) * Sin[k * 64 + v];
            const float ms = wave_sum(o * o) * (1.f / 64.f); const float on = o * (1.f / sqrtf(ms + EPS)) * ng[v];
            const float z = bf2f(F.PROJ()[(size_t)(r0 + t) * NP + C_GZ + h * 64 + v]);
            F.YMIX()[(size_t)(r0 + t) * D + 256 + h * 64 + v] = (bf16)f2bf(on * silu_f(z)); }
        __syncthreads();
    }
}
__device__ __forceinline__ void swa_naive(Frame& F, int l) {
    { int t_ = threadIdx.x; asm volatile("" : "+v"(t_)); F.tid = t_; F.lane = t_ & 63; F.wave = __builtin_amdgcn_readfirstlane(t_ >> 6); }
    float* Kf = F.ldsf; float* Vf = F.ldsf + 256 * 65;
    for (int u = blockIdx.x; u < 256; u += F.G) {
        const int hk = u & 1, n = (u >> 1) & 63, b = u >> 7;
        const int rq0 = b * SEQ + n * 128, rk0 = rq0 - 128;
        for (int idx = F.tid; idx < 256 * 32; idx += 512) { const int j = idx >> 5, dp = idx & 31; float k1 = 0.f, k2 = 0.f, v1 = 0.f, v2 = 0.f;
            if (n > 0 || j >= 128) { const size_t r = (size_t)(rk0 + j); const bf16* pr = F.PROJ() + r * NP;
                const float x1 = bf2f(pr[C_SK + hk * 64 + dp]), x2 = bf2f(pr[C_SK + hk * 64 + dp + 32]); const f32x2 cs = F.ROPE()[r * 32 + dp];
                k1 = x1 * cs.x - x2 * cs.y; k2 = x2 * cs.x + x1 * cs.y; v1 = bf2f(pr[C_SV + hk * 64 + dp]); v2 = bf2f(pr[C_SV + hk * 64 + dp + 32]); }
            Kf[j * 65 + dp] = k1; Kf[j * 65 + dp + 32] = k2; Vf[j * 64 + dp] = v1; Vf[j * 64 + dp + 32] = v2; }
        __syncthreads();
        const int i = F.tid >> 2, part = F.tid & 3; const size_t rq = (size_t)(rq0 + i);
        for (int g = 0; g < 4; ++g) { const int qh = hk * 4 + g;
            float q[64];
            { const bf16* pr = F.PROJ() + rq * NP + C_SQ + qh * 64;
#pragma unroll
                for (int d = 0; d < 32; ++d) { const float x1 = bf2f(pr[d]), x2 = bf2f(pr[d + 32]); const f32x2 cs = F.ROPE()[rq * 32 + d]; q[d] = (x1 * cs.x - x2 * cs.y) * 0.125f; q[d + 32] = (x2 * cs.x + x1 * cs.y) * 0.125f; } }
            const float sink = F.swa_sinks()[l * 8 + qh];
            float mx = sink, lsum = (part == 0) ? 1.f : 0.f; float o[64];
#pragma unroll
            for (int d = 0; d < 64; ++d) o[d] = 0.f;
            for (int jj = 0; jj < 64; ++jj) { const int key = 4 * jj + part; const bool valid = (key > i) && (key <= i + 128) && (n > 0 || key >= 128);
                if (valid) { const float* kr = Kf + key * 65; float s = 0.f;
#pragma unroll
                    for (int d = 0; d < 64; ++d) s += q[d] * kr[d];
                    const float mn = fmaxf(mx, s), sc_ = __expf(mx - mn), p = __expf(s - mn); lsum = lsum * sc_ + p; const float* vr = Vf + key * 64;
#pragma unroll
                    for (int d = 0; d < 64; ++d) o[d] = o[d] * sc_ + p * vr[d];
                    mx = mn; } }
            float mt = fmaxf(mx, __shfl_xor(mx, 1)); mt = fmaxf(mt, __shfl_xor(mt, 2)); const float f = __expf(mx - mt);
            lsum *= f; lsum += __shfl_xor(lsum, 1); lsum += __shfl_xor(lsum, 2); const float inv = 1.f / lsum;
            const bf16* pz = F.PROJ() + rq * NP + C_SZ + qh * 64; bf16* py = F.YMIX() + rq * D + 512 + qh * 64;
#pragma unroll
            for (int d = 0; d < 64; ++d) { float xx = o[d] * f; xx += __shfl_xor(xx, 1); xx += __shfl_xor(xx, 2); xx *= inv;
                if ((d >> 4) == part) py[d] = (bf16)f2bf(xx * silu_f(bf2f(pz[d]))); }
        }
        __syncthreads();
    }
}
__device__ __forceinline__ void resid_rows(Frame& F, int l) {
    { int t_ = threadIdx.x; asm volatile("" : "+v"(t_)); F.tid = t_; F.lane = t_ & 63; F.wave = __builtin_amdgcn_readfirstlane(t_ >> 6); }
    const int gw = F.vcu * NWAVES + F.wave, NGW = F.G * NWAVES;
    const float* xin = (l == 0) ? F.x() : F.outp(); const GAS f32x4* pg = (const GAS f32x4*)(F.post_g() + l * D) + F.lane;
    for (int m = gw; m < M; m += NGW) {
        float sy = (F.lane < 16) ? F.SSQP()[(size_t)m * 16 + F.lane] : 0.f; sy = wave_sum(sy);
        const float ry = 1.f / sqrtf(sy * (1.f / D) + EPS);
        const GAS f32x4* xr = (const GAS f32x4*)(xin + (size_t)m * D) + F.lane; const GAS f32x4* yr = (const GAS f32x4*)(F.Y() + (size_t)m * D) + F.lane;
        GAS f32x4* orow = (GAS f32x4*)(F.outp() + (size_t)m * D) + F.lane;
        f32x4 v[4]; float s = 0.f;
#pragma unroll
        for (int j = 0; j < 4; ++j) { v[j] = xr[64 * j] + yr[64 * j] * ry * pg[64 * j]; s += (v[j].x * v[j].x + v[j].y * v[j].y) + (v[j].z * v[j].z + v[j].w * v[j].w); orow[64 * j] = v[j]; }
        s = wave_sum(s);
        if (F.lane == 0) F.RSTD()[m] = 1.f / sqrtf(s * (1.f / D) + EPS);
        GAS unsigned long long* o8 = (GAS unsigned long long*)(F.XB() + (size_t)m * D) + F.lane;
#pragma unroll
        for (int j = 0; j < 4; ++j) o8[64 * j] = (unsigned long long)pk2(v[j].x, v[j].y) | ((unsigned long long)pk2(v[j].z, v[j].w) << 32);
    }
}

struct Args { const void* in[14]; float* out; unsigned char* ws; int ph_lo, ph_hi; };
__global__ void __launch_bounds__(NWAVES * 64, 2) hybrid_fwd(Args args) {
    extern __shared__ __attribute__((aligned(16))) unsigned char lds[];
    Frame F;
    F.lds = (LAS unsigned char*)lds; F.ldsf = (float*)lds;
    F.MISC = (volatile LAS unsigned*)(F.lds + MISC_OFF);
    F.tid = threadIdx.x; F.lane = F.tid & 63; F.wave = __builtin_amdgcn_readfirstlane(F.tid >> 6);
    F.G = gridDim.x; { const int bx = blockIdx.x; F.vcu = (F.G % 8 == 0) ? (bx % 8) * (F.G / 8) + bx / 8 : bx; }
    for (int u = F.tid; u < (LDS_BYTES - LDSCTL_OFF) / 4; u += NWAVES * 64) ((LAS unsigned*)(F.lds + LDSCTL_OFF))[u] = 0u;
    __syncthreads();
    if (MK_ONE_LAUNCH) (void)xcd_barrier_post((unsigned*)(F.ctl() + CW_BAR), F.MISC + 8);
#define PH_LO (((const volatile int __attribute__((address_space(4)))*)__builtin_amdgcn_kernarg_segment_ptr())[32])
#define PH_HI (((const volatile int __attribute__((address_space(4)))*)__builtin_amdgcn_kernarg_segment_ptr())[33])
#define IN(k) (PH_LO <= (k) && (k) < PH_HI)
#define SEAM(k) do { if (IN(k) && IN((k) + 1)) { XcdBarrier bar_; bar_.bar = (unsigned*)(F.ctl() + CW_BAR); bar_.x = xb_xcc_id(); bar_.st = F.MISC + 8; xcd_barrier(bar_); } } while (0)

    if (IN(0)) { p0_prologue(F); } SEAM(0);
    for (int l = 0; l < DEPTH; ++l) {
        const int p = 1 + l * PH_PER_LAYER;
        if (IN(p)) {
            pg8::Gemm g{F.XB(), F.Win_t() + (size_t)l * NP * D, M, NP, D}; pg8::StaticOrder S; S.init(M, NP, F.G, (int)blockIdx.x);
            pg8::EpiProj E{F.PROJ(), NP, F.RSTD()};
            pg8::gemm_phase<pg8::EpiProj, pg8::StaticOrder, true, true>(F.lds, g, S, E);
        } SEAM(p);
        if (IN(p + 1)) { sgu_naive(F, l); gla_summ_naive(F, l); swa_naive(F, l); } SEAM(p + 1);
        if (IN(p + 2)) { gla_out_naive(F, l); } SEAM(p + 2);
        if (IN(p + 3)) {
            pg8::Gemm g{F.YMIX(), F.Wout_t() + (size_t)l * D * D, M, D, D}; pg8::StaticOrder S; S.init(M, D, F.G, (int)blockIdx.x);
            pg8::EpiY E{F.Y(), D, F.SSQP()};
            pg8::gemm_phase<pg8::EpiY, pg8::StaticOrder, false, true>(F.lds, g, S, E);
        } SEAM(p + 3);
        if (IN(p + 4)) { resid_rows(F, l); } SEAM(p + 4);
    }
#undef IN
#undef SEAM
}

extern "C" void kernel_launch(void* const* d_in, const int* in_sizes, int n_in, void* d_out, int out_size, void* d_ws, size_t ws_size, hipStream_t stream) {
    static int grid = 0;
    if (grid == 0) {
        if (n_in != 14 || in_sizes[0] != M * D || out_size != M * D || ws_size < WS_END) { fprintf(stderr, "kernel_launch: unexpected shapes (n_in %d, in0 %d, out %d, ws %zu); nothing launched\n", n_in, n_in > 0 ? in_sizes[0] : -1, out_size, ws_size); grid = -1; return; }
        int dev = 0, cus = 0, per_cu = 0;
        if (hipGetDevice(&dev) != hipSuccess || hipDeviceGetAttribute(&cus, hipDeviceAttributeMultiprocessorCount, dev) != hipSuccess) { grid = -1; return; }
        if (hipFuncSetAttribute((const void*)hybrid_fwd, hipFuncAttributeMaxDynamicSharedMemorySize, LDS_BYTES) != hipSuccess) { fprintf(stderr, "kernel_launch: hipFuncSetAttribute failed\n"); grid = -1; return; }
        if (hipOccupancyMaxActiveBlocksPerMultiprocessor(&per_cu, (const void*)hybrid_fwd, NWAVES * 64, LDS_BYTES) != hipSuccess || per_cu < 1) { fprintf(stderr, "kernel_launch: occupancy query says %d blocks per CU; nothing launched\n", per_cu); (void)hipGetLastError(); grid = -1; return; }
        grid = cus;
        if (grid > 256) grid = 256;
    }
    if (grid < 0) return;
    (void)hipMemsetAsync((char*)d_ws + WS_CTL, 0, CTL_ZERO_BYTES, stream);
    Args a{};
    for (int i = 0; i < 14; ++i) a.in[i] = d_in[i];
    a.out = (float*)d_out; a.ws = (unsigned char*)d_ws;
#if MK_ONE_LAUNCH
    a.ph_lo = 0; a.ph_hi = N_PHASES;
    hipLaunchKernelGGL(hybrid_fwd, dim3(grid), dim3(NWAVES * 64), LDS_BYTES, stream, a);
#else
    for (int p = 0; p < N_PHASES; ++p) { a.ph_lo = p; a.ph_hi = p + 1; hipLaunchKernelGGL(hybrid_fwd, dim3(grid), dim3(NWAVES * 64), LDS_BYTES, stream, a); }
#endif
}
```

```cpp
#include <hip/hip_runtime.h>
#include <cstdio>
#include <cstdint>
#define MK_ONE_LAUNCH 1
#define MK_SWA_MFMA 1
#define MK_SGU_MFMA 1
#define MK_GLA_MFMA 1

constexpr int NWAVES = 8;
#ifndef MK_ONE_LAUNCH
#define MK_ONE_LAUNCH 1
#endif

constexpr int BATCH = 2, SEQ = 8192, D = 1024, DEPTH = 4, M = BATCH * SEQ;
constexpr int D_IN = 2832, NP = 3072;
constexpr int C_GMU = 0, C_GMV = 256, C_GMZ = 512, C_GQ = 768, C_GK = 896, C_GV = 1024, C_GLG = 1280, C_GZ = 1408, C_SQ = 1664, C_SK = 2176, C_SV = 2304, C_SZ = 2432, C_END = 2944;
constexpr int S_GLR = 1280;
constexpr float EPS = 1e-6f;
constexpr float LOG2E = 1.4426950408889634f, QSCALE = 0.125f * LOG2E;
constexpr int PH_PER_LAYER = 5, N_PHASES = 1 + DEPTH * PH_PER_LAYER;

constexpr size_t MiB = 1u << 20;
constexpr size_t WS_CTL = 0, CTL_ZERO_BYTES = 1 * MiB;
constexpr size_t WS_WIN = 2 * MiB;
constexpr size_t WS_WOUT = 26 * MiB;
constexpr size_t WS_ROPE = 34 * MiB;
constexpr size_t WS_SSQP = 38 * MiB;
constexpr size_t WS_RSTD = 39 * MiB;
constexpr size_t WS_GLAU = 40 * MiB;
constexpr size_t WS_GLAA = 44 * MiB;
constexpr size_t WS_WSGU = 45 * MiB;
constexpr size_t WS_XB = 48 * MiB;
constexpr size_t WS_YMIX = 80 * MiB;
constexpr size_t WS_PROJ = 112 * MiB;
constexpr size_t WS_Y = WS_PROJ;
constexpr size_t WS_END = 208 * MiB;
constexpr int CW_BAR = 4096;

constexpr int LDS_BYTES = 163840;
constexpr int LDSCTL_OFF = LDS_BYTES - 1024, MISC_OFF = LDSCTL_OFF + 320;

namespace pg8 {
#define PG8_LAS __attribute__((address_space(3)))
typedef unsigned short bf16_t;
typedef short bf16x8 __attribute__((ext_vector_type(8)));
typedef float f32x4 __attribute__((ext_vector_type(4)));
typedef unsigned u32x4 __attribute__((ext_vector_type(4)));
constexpr int BM = 256, BK = 64, HALF = 128, HTB = HALF * BK * 2  , STAGE_BYTES = 8 * HTB, NXCD = 8, WGM = 8;

__host__ __device__ __forceinline__ int lds_byte(int r, int c) { const int st = (r >> 4) * 2 + (c >> 5), rr = r & 15, cc = c & 31, ob = rr * 64 + cc * 2; return st * 1024 + (ob ^ (((ob >> 9) & 1) << 5)); }
__host__ __device__ __forceinline__ void stage_rc(int b, int& R, int& C) { const int st = b / 1024, sb = b % 1024, swz = sb ^ (((sb >> 9) & 1) << 5); R = (st >> 1) * 16 + swz / 64; C = (st & 1) * 32 + (swz % 64) / 2; }
__host__ __device__ __forceinline__ int perm32(int rho) { const int n = rho >> 4, i = rho & 15; return 8 * (i >> 2) + 4 * n + (i & 3); }

struct Unit { int pm, pn; };
struct Gemm { const bf16_t* A; const bf16_t* Bt; int M, N, K; };

struct StaticOrder {
    int nM, nN, nwg, G, c;
    __host__ __device__ void init(int M, int N, int G_, int c_) { nM = M / BM; nN = N / BM; nwg = nM * nN; G = G_; c = c_; }
    __host__ __device__ bool next(int i, Unit& u) const {
        const long L = (long)i * G + c; if (L >= nwg) return false;
        int wgid = (int)L; { const int q = nwg / NXCD, r = nwg % NXCD, xcd = wgid % NXCD, off = wgid / NXCD; wgid = (xcd < r ? xcd * (q + 1) : r * (q + 1) + (xcd - r) * q) + off; }
        const int nig = WGM * nN, gid = wgid / nig, fm = gid * WGM, gsz = (nM - fm) < WGM ? (nM - fm) : WGM;
        u.pm = fm + ((wgid % nig) % gsz); u.pn = (wgid % nig) / gsz; return true;
    }
    __device__ __forceinline__ void a_ready(const Unit&) const {}
    __device__ __forceinline__ void done(const Unit&) const {}
};


__device__ __forceinline__ unsigned cvt_pk_bf16(float lo, float hi) { unsigned r; asm volatile("v_cvt_pk_bf16_f32 %0, %1, %2" : "=v"(r) : "v"(lo), "v"(hi)); return r; }

struct EpiProj {
    static constexpr bool PERM = true, AFTER_DRAIN = false;
    bf16_t* O; int ldc; const float* rstd; const float* rope;
    __device__ __forceinline__ void operator()(const f32x4 (&acc)[2][2][4][2], const Unit& u, int wr, int wc, int fr, int fq) const {
        const int row0 = u.pm * BM + wr * 64 + fr, col0 = u.pn * BM + wc * 32 + 8 * fq;
#pragma unroll
        for (int bj = 0; bj < 2; ++bj) { const int cg = u.pn * BM + bj * HALF + wc * 32; const bool rot = (cg >= C_SQ) && (cg < C_SV); const float qs = (cg < C_SK) ? QSCALE : 1.f;
            const int dd = ((col0 + bj * HALF - C_SQ) & 63) >> 1;
#pragma unroll
            for (int ai = 0; ai < 2; ++ai)
#pragma unroll
                for (int m = 0; m < 4; ++m) { const int row = row0 + ai * HALF + m * 16; const float sc = rstd[row]; bf16_t* rowp = O + (size_t)row * ldc + col0;
                    f32x4 v0 = acc[ai][bj][m][0] * sc, v1 = acc[ai][bj][m][1] * sc;
                    if (rot) { const f32x4 a = *(const f32x4*)(rope + ((size_t)row * 32 + dd) * 2), b = *(const f32x4*)(rope + ((size_t)row * 32 + dd + 2) * 2);
                        const f32x4 c = {a[0], a[2], b[0], b[2]}, s = {a[1], a[3], b[1], b[3]};
                        const f32x4 o1 = (v0 * c - v1 * s) * qs, o2 = (v1 * c + v0 * s) * qs; v0 = o1; v1 = o2; }
                    u32x4 w; w.x = cvt_pk_bf16(v0[0], v0[1]); w.y = cvt_pk_bf16(v0[2], v0[3]); w.z = cvt_pk_bf16(v1[0], v1[1]); w.w = cvt_pk_bf16(v1[2], v1[3]);
                    *(u32x4*)(rowp + bj * HALF) = w; } }
    }
};
struct EpiY {
    static constexpr bool PERM = false, AFTER_DRAIN = false;
    float* Y; int ldc; float* ssq;
    __device__ __forceinline__ void operator()(const f32x4 (&acc)[2][2][4][2], const Unit& u, int wr, int wc, int fr, int fq) const {
        const int row0 = u.pm * BM + wr * 64 + fr, col0 = u.pn * BM + wc * 32 + 4 * fq;
#pragma unroll
        for (int ai = 0; ai < 2; ++ai)
#pragma unroll
            for (int m = 0; m < 4; ++m) { const int row = row0 + ai * HALF + m * 16; float* rowp = Y + (size_t)row * ldc + col0; float s = 0.f;
#pragma unroll
                for (int bj = 0; bj < 2; ++bj)
#pragma unroll
                    for (int n = 0; n < 2; ++n) { const f32x4 v = acc[ai][bj][m][n]; s += (v[0] * v[0] + v[1] * v[1]) + (v[2] * v[2] + v[3] * v[3]); *(f32x4*)(rowp + bj * HALF + n * 16) = v; }
                s += __shfl_xor(s, 16); s += __shfl_xor(s, 32);
                if (fq == 0) ssq[(size_t)row * 16 + u.pn * 4 + wc] = s; }
    }
};
template <class Epi, class Sched, bool ALIGN_EPI = false, bool SP2 = false>
__device__ __forceinline__ void gemm_phase(PG8_LAS unsigned char* lds, const Gemm g, const Sched& S, const Epi& E) {
    const int tid = threadIdx.x, wid = __builtin_amdgcn_readfirstlane(tid >> 6), lane = tid & 63, wr = wid >> 2, wc = wid & 3, fr = lane & 15, fq = lane >> 4;
    const int K = g.K, nt = K / BK;
    unsigned voffA[2], voffB[2];
#pragma unroll
    for (int i = 0; i < 2; ++i) { int R, C; stage_rc(tid * 16 + i * 8192, R, C); const int Rb = Epi::PERM ? ((R & ~31) + perm32(R & 31)) : R;
        voffA[i] = (unsigned)(R * K + C) * 2u; voffB[i] = (unsigned)(Rb * K + C) * 2u; }
    const size_t kstep = (size_t)(BK * 2);
    const size_t hstep = (size_t)HALF * K * 2;
    const size_t tstep = 2 * hstep;
    const unsigned ldsw = (unsigned)wid * 1024u;
    const int aoff = lds_byte(wr * 64 + fr, fq * 8), boff = lds_byte(wc * 32 + fr, fq * 8);
#define PG8_SA(b, h) (((b) * 2 + (h)) * HTB)
#define PG8_SB(b, h) ((4 + (b) * 2 + (h)) * HTB)
#define PG8_STAGE(bufoff, gbase, voff) do { _Pragma("unroll") for (int _i = 0; _i < 2; ++_i) \
        __builtin_amdgcn_global_load_lds((const unsigned*)((const char*)(gbase) + (voff)[_i]), (PG8_LAS unsigned*)(lds + (bufoff) + ldsw + _i * 8192), 16, 0, 0); } while (0)
#define PG8_LDA(dst, b, h) do { _Pragma("unroll") for (int m = 0; m < 4; ++m) _Pragma("unroll") for (int k = 0; k < 2; ++k) dst[m][k] = *(const PG8_LAS bf16x8*)(lds + PG8_SA(b, h) + aoff + m * 2048 + k * 1024); } while (0)
#define PG8_LDB(dst, b, h) do { _Pragma("unroll") for (int n = 0; n < 2; ++n) _Pragma("unroll") for (int k = 0; k < 2; ++k) dst[n][k] = *(const PG8_LAS bf16x8*)(lds + PG8_SB(b, h) + boff + n * 2048 + k * 1024); } while (0)
#define PG8_MMA(ai, bj, At, Bt) do { __builtin_amdgcn_s_setprio(1); _Pragma("unroll") for (int m = 0; m < 4; ++m) _Pragma("unroll") for (int n = 0; n < 2; ++n) _Pragma("unroll") for (int k = 0; k < 2; ++k) \
        acc[ai][bj][m][n] = __builtin_amdgcn_mfma_f32_16x16x32_bf16(Bt[n][k], At[m][k], acc[ai][bj][m][n], 0, 0, 0); __builtin_amdgcn_s_setprio(0); } while (0)
#define PG8_WAIT_V(n) asm volatile("s_waitcnt vmcnt(" #n ")" ::: "memory")
#define PG8_WAIT_L(n) asm volatile("s_waitcnt lgkmcnt(" #n ")" ::: "memory")
#define PG8_BAR __builtin_amdgcn_s_barrier()
#define PG8_SCHED __builtin_amdgcn_sched_barrier(0)
    Unit cur, nxt; int ui = 0;
    if (!S.next(0, cur)) return;
    f32x4 acc[2][2][4][2];
#pragma unroll
    for (int a = 0; a < 2; ++a)
#pragma unroll
        for (int b = 0; b < 2; ++b)
#pragma unroll
            for (int m = 0; m < 4; ++m)
#pragma unroll
                for (int n = 0; n < 2; ++n) acc[a][b][m][n] = (f32x4){0.f, 0.f, 0.f, 0.f};
    bf16x8 At[4][2], B0[2][2], B1[2][2];
    const char* cA = (const char*)g.A + (size_t)cur.pm * tstep; const char* cB = (const char*)g.Bt + (size_t)cur.pn * tstep;
    S.a_ready(cur);
    if constexpr (SP2) {
        PG8_STAGE(PG8_SB(0, 0), cB, voffB); PG8_STAGE(PG8_SB(0, 1), cB + hstep, voffB); PG8_STAGE(PG8_SA(0, 0), cA, voffA); PG8_STAGE(PG8_SA(0, 1), cA + hstep, voffA);
        if (wr == 1) PG8_BAR;
        PG8_WAIT_V(2); PG8_BAR;
        PG8_STAGE(PG8_SB(1, 0), cB + kstep, voffB); PG8_STAGE(PG8_SA(1, 0), cA + kstep, voffA); PG8_STAGE(PG8_SB(1, 1), cB + hstep + kstep, voffB);
        PG8_WAIT_V(6); PG8_BAR;
    } else {
        PG8_STAGE(PG8_SB(0, 0), cB, voffB); PG8_STAGE(PG8_SA(0, 0), cA, voffA); PG8_STAGE(PG8_SB(0, 1), cB + hstep, voffB); PG8_STAGE(PG8_SA(0, 1), cA + hstep, voffA);
        if (wr == 1) PG8_BAR;
        PG8_WAIT_V(4); PG8_BAR;
        PG8_STAGE(PG8_SB(1, 0), cB + kstep, voffB); PG8_STAGE(PG8_SA(1, 0), cA + kstep, voffA); PG8_STAGE(PG8_SB(1, 1), cB + hstep + kstep, voffB);
        PG8_WAIT_V(6); PG8_BAR;
    }
    for (;;) {
        const bool has_next = S.next(ui + 1, nxt);
        const char* nA = has_next ? (const char*)g.A + (size_t)nxt.pm * tstep : cA; const char* nB = has_next ? (const char*)g.Bt + (size_t)nxt.pn * tstep : cB;
        for (int t = 0; t < nt; t += 2) {
            const bool last = (t == nt - 2);
            const char* a1 = cA + (size_t)(t + 1) * kstep;
            const char* a2 = last ? nA : cA + (size_t)(t + 2) * kstep; const char* b2 = last ? nB : cB + (size_t)(t + 2) * kstep;
            const char* a3 = a2 + kstep; const char* b3 = b2 + kstep;
            if (last && has_next) S.a_ready(nxt);
            if constexpr (SP2) {
            PG8_LDB(B0, 0, 0); PG8_LDB(B1, 0, 1); PG8_SCHED; PG8_LDA(At, 0, 0); PG8_STAGE(PG8_SA(1, 1), a1 + hstep, voffA);
            PG8_WAIT_V(8); PG8_WAIT_L(0); PG8_BAR; PG8_MMA(0, 0, At, B0); PG8_MMA(0, 1, At, B1); PG8_BAR; PG8_SCHED;
            PG8_LDA(At, 0, 1); PG8_STAGE(PG8_SB(0, 0), b2, voffB); PG8_STAGE(PG8_SB(0, 1), b2 + hstep, voffB); PG8_STAGE(PG8_SA(0, 0), a2, voffA);
            PG8_WAIT_V(8); PG8_WAIT_L(0); PG8_BAR; PG8_MMA(1, 0, At, B0); PG8_MMA(1, 1, At, B1); PG8_BAR; PG8_SCHED;
            PG8_LDB(B0, 1, 0); PG8_LDB(B1, 1, 1); PG8_SCHED; PG8_LDA(At, 1, 0); PG8_STAGE(PG8_SA(0, 1), a2 + hstep, voffA);
            PG8_WAIT_V(8); PG8_WAIT_L(0); PG8_BAR; PG8_MMA(0, 0, At, B0); PG8_MMA(0, 1, At, B1); PG8_BAR; PG8_SCHED;
            PG8_LDA(At, 1, 1); PG8_STAGE(PG8_SB(1, 0), b3, voffB); PG8_STAGE(PG8_SB(1, 1), b3 + hstep, voffB); PG8_STAGE(PG8_SA(1, 0), a3, voffA);
            PG8_WAIT_V(8); PG8_WAIT_L(0); PG8_BAR; PG8_MMA(1, 0, At, B0); PG8_MMA(1, 1, At, B1); PG8_BAR; PG8_SCHED;
            } else {
            PG8_LDB(B0, 0, 0); PG8_SCHED; PG8_LDA(At, 0, 0); PG8_STAGE(PG8_SA(1, 1), a1 + hstep, voffA);
            PG8_WAIT_L(8); PG8_BAR; PG8_WAIT_L(0); PG8_MMA(0, 0, At, B0); PG8_BAR; PG8_SCHED;
            PG8_LDB(B1, 0, 1); PG8_STAGE(PG8_SB(0, 0), b2, voffB);
            PG8_BAR; PG8_WAIT_L(0); PG8_MMA(0, 1, At, B1); PG8_BAR;
            PG8_LDA(At, 0, 1); PG8_STAGE(PG8_SA(0, 0), a2, voffA);
            PG8_BAR; PG8_WAIT_L(0); PG8_MMA(1, 0, At, B0); PG8_BAR; PG8_SCHED;
            PG8_STAGE(PG8_SB(0, 1), b2 + hstep, voffB);
            PG8_WAIT_V(6); PG8_BAR; PG8_MMA(1, 1, At, B1); PG8_BAR;
            PG8_LDB(B0, 1, 0); PG8_SCHED; PG8_LDA(At, 1, 0); PG8_STAGE(PG8_SA(0, 1), a2 + hstep, voffA);
            PG8_WAIT_L(8); PG8_BAR; PG8_WAIT_L(0); PG8_MMA(0, 0, At, B0); PG8_BAR; PG8_SCHED;
            PG8_LDB(B1, 1, 1); PG8_STAGE(PG8_SB(1, 0), b3, voffB);
            PG8_BAR; PG8_WAIT_L(0); PG8_MMA(0, 1, At, B1); PG8_BAR;
            PG8_LDA(At, 1, 1); PG8_STAGE(PG8_SA(1, 0), a3, voffA);
            PG8_BAR; PG8_WAIT_L(0); PG8_MMA(1, 0, At, B0); PG8_BAR; PG8_SCHED;
            PG8_STAGE(PG8_SB(1, 1), b3 + hstep, voffB);
            PG8_WAIT_V(6); PG8_BAR; PG8_MMA(1, 1, At, B1); PG8_BAR;
            }
        }
        if constexpr (ALIGN_EPI) { if (wr == 0) PG8_BAR; }
        if constexpr (!Epi::AFTER_DRAIN) { E(acc, cur, wr, wc, fr, fq); S.done(cur); }
        if (!has_next) break;
#pragma unroll
        for (int a = 0; a < 2; ++a)
#pragma unroll
            for (int b = 0; b < 2; ++b)
#pragma unroll
                for (int m = 0; m < 4; ++m)
#pragma unroll
                    for (int n = 0; n < 2; ++n) acc[a][b][m][n] = (f32x4){0.f, 0.f, 0.f, 0.f};
        cur = nxt; cA = nA; cB = nB; ++ui;
        if constexpr (ALIGN_EPI) { if (wr == 1) PG8_BAR; }
    }
    PG8_WAIT_V(0);
    if constexpr (!ALIGN_EPI) { if (wr == 0) PG8_BAR; }
    PG8_BAR;
    if constexpr (Epi::AFTER_DRAIN) { E.fused(acc, cur, wr, wc, fr, fq, lds, wid, lane); S.done(cur); }
#undef PG8_SA
#undef PG8_SB
#undef PG8_STAGE
#undef PG8_LDA
#undef PG8_LDB
#undef PG8_MMA
#undef PG8_WAIT_V
#undef PG8_WAIT_L
#undef PG8_BAR
#undef PG8_SCHED
}
}
#define GAS __attribute__((address_space(1)))
#define LAS __attribute__((address_space(3)))
typedef unsigned short bf16;
typedef unsigned v4u __attribute__((ext_vector_type(4)));
typedef float f32x4 __attribute__((ext_vector_type(4)));
typedef short bf16x8 __attribute__((ext_vector_type(8)));
typedef GAS unsigned gu32;
typedef GAS unsigned long long gu64;
#define RLX_AGENT __ATOMIC_RELAXED, __HIP_MEMORY_SCOPE_AGENT
#define LDS_WAIT() asm volatile("s_waitcnt lgkmcnt(0)" ::: "memory")
#define VM_WAIT() asm volatile("s_waitcnt vmcnt(0)" ::: "memory")
__device__ __forceinline__ unsigned long long rt() { return __builtin_amdgcn_s_memrealtime(); }
__device__ __forceinline__ unsigned f2bf(float f) { unsigned u = __builtin_bit_cast(unsigned, f); return (u + 0x7fffu + ((u >> 16) & 1u)) >> 16; }
__device__ __forceinline__ unsigned pk2(float lo, float hi) { return f2bf(lo) | (f2bf(hi) << 16); }

#define XB_TMO      128
#define XB_XCNT(j)  (256  + 64 * (j))
#define XB_XSUB(j)  (1280 + 64 * (j))
#define XB_XGEN(j)  (2304 + 64 * (j))
#define XB_TOP      3328
#define XB_TOPGEN   3392
#define XCD_BAR_WORDS 3456
#define XB_SPIN_CAP (1u << 18)

__device__ __forceinline__ unsigned xb_ld(unsigned* p)              { return __hip_atomic_load(p, __ATOMIC_RELAXED, __HIP_MEMORY_SCOPE_AGENT); }
__device__ __forceinline__ unsigned xb_add(unsigned* p, unsigned v) { return __hip_atomic_fetch_add(p, v, __ATOMIC_RELAXED, __HIP_MEMORY_SCOPE_AGENT); }
__device__ __forceinline__ unsigned xb_xcc_id() { return (unsigned)__builtin_amdgcn_s_getreg((3 << 11) | 20) & 0xFu; }
#define XB_SPIN(cond, bar) do { unsigned _sp = 0; while (cond) { __builtin_amdgcn_s_sleep(1); \
    if ((++_sp & 255u) == 0u) { if (xb_ld(&(bar)[XB_TMO])) break; if (_sp > XB_SPIN_CAP) { atomicAdd(&(bar)[XB_TMO], 1u); break; } } } } while (0)

struct XcdBarrier {
    unsigned* bar; unsigned x;
    volatile LAS unsigned* st;
};

__device__ __forceinline__ XcdBarrier xcd_barrier_post(unsigned* bar, volatile LAS unsigned* st) {
    XcdBarrier b; b.bar = bar; b.x = xb_xcc_id(); b.st = st;
    if (threadIdx.x == 0) (void)xb_add(&bar[XB_XCNT(b.x)], 1u);
    return b;
}
__device__ __forceinline__ void xcd_barrier_complete(unsigned* bar, unsigned x, unsigned& nloc, unsigned& nx) {
    const unsigned G = gridDim.x * gridDim.y * gridDim.z;
    unsigned sum, cnt, mine, sp = 0u;
    for (;;) {
        sum = 0u; cnt = 0u; mine = 0u;
#pragma unroll
        for (unsigned j = 0; j < 16; ++j) { const unsigned c = xb_ld(&bar[XB_XCNT(j)]); sum += c; cnt += (c > 0u) ? 1u : 0u; mine = (j == x) ? c : mine; }
        if (sum == G) break;
        __builtin_amdgcn_s_sleep(1);
        if ((++sp & 255u) == 0u) { if (xb_ld(&bar[XB_TMO])) break; if (sp > XB_SPIN_CAP) { atomicAdd(&bar[XB_TMO], 1u); break; } }
    }
    nloc = mine > 0u ? mine : 1u; nx = cnt > 0u ? cnt : 1u;
}

__device__ __forceinline__ void xcd_barrier(const XcdBarrier& b) {
    asm volatile("s_waitcnt vmcnt(0)" ::: "memory");
    __syncthreads();
    if (threadIdx.x == 0) {
        unsigned* bar = b.bar;
        __builtin_amdgcn_s_waitcnt(0);
        unsigned nloc = b.st[0], nx = b.st[1];
        if (nloc == 0u) { xcd_barrier_complete(bar, b.x, nloc, nx); b.st[0] = nloc; b.st[1] = nx; }
        const unsigned old = xb_add(&bar[XB_XSUB(b.x)], 1u);
        const unsigned gen = old / nloc;
        if (old + 1u == (gen + 1u) * nloc) {
            __builtin_amdgcn_fence(__ATOMIC_RELEASE, "agent");
            asm volatile("s_waitcnt vmcnt(0)" ::: "memory");
            const unsigned og = xb_add(&bar[XB_TOP], 1u);
            const unsigned tg = og / nx;
            if (og + 1u == (tg + 1u) * nx) xb_add(&bar[XB_TOPGEN], 1u);
            else XB_SPIN(xb_ld(&bar[XB_TOPGEN]) == tg, bar);
            __builtin_amdgcn_fence(__ATOMIC_ACQUIRE, "agent");
            xb_add(&bar[XB_XGEN(b.x)], 1u);
            asm volatile("s_waitcnt vmcnt(0)" ::: "memory");
        } else {
            XB_SPIN(xb_ld(&bar[XB_XGEN(b.x)]) == gen, bar);
            __builtin_amdgcn_fence(__ATOMIC_ACQUIRE, "agent");
            asm volatile("s_waitcnt vmcnt(0)" ::: "memory");
        }
    }
    __syncthreads();
}

typedef float f32x2 __attribute__((ext_vector_type(2)));
typedef unsigned v2u __attribute__((ext_vector_type(2)));
#define KIN(i) (((const void* const volatile __attribute__((address_space(4)))*)__builtin_amdgcn_kernarg_segment_ptr())[i])
struct Frame {
    LAS unsigned char* lds;
    float* ldsf;
    volatile LAS unsigned* MISC;
    int tid, lane, wave;
    int vcu, G;
    __device__ __forceinline__ float* outp() const { return (float*)KIN(14); }
    __device__ __forceinline__ unsigned char* wsp() const { return (unsigned char*)KIN(15); }
    __device__ __forceinline__ gu32* ctl() const { return (gu32*)(wsp() + WS_CTL); }
    __device__ __forceinline__ const float* x() const { return (const float*)KIN(0); }
    __device__ __forceinline__ const int* positions() const { return (const int*)KIN(1); }
    __device__ __forceinline__ const float* pre_g() const { return (const float*)KIN(2); }
    __device__ __forceinline__ const float* w_in() const { return (const float*)KIN(3); }
    __device__ __forceinline__ const float* gm_ln_g() const { return (const float*)KIN(4); }
    __device__ __forceinline__ const float* gm_ln_b() const { return (const float*)KIN(5); }
    __device__ __forceinline__ const float* gm_ws() const { return (const float*)KIN(6); }
    __device__ __forceinline__ const float* gm_bs() const { return (const float*)KIN(7); }
    __device__ __forceinline__ const float* gla_wg2() const { return (const float*)KIN(8); }
    __device__ __forceinline__ const float* gla_bg() const { return (const float*)KIN(9); }
    __device__ __forceinline__ const float* gla_norm_g() const { return (const float*)KIN(10); }
    __device__ __forceinline__ const float* swa_sinks() const { return (const float*)KIN(11); }
    __device__ __forceinline__ const float* w_out() const { return (const float*)KIN(12); }
    __device__ __forceinline__ const float* post_g() const { return (const float*)KIN(13); }
    __device__ __forceinline__ bf16* Win_t() const { return (bf16*)(wsp() + WS_WIN); }
    __device__ __forceinline__ bf16* Wout_t() const { return (bf16*)(wsp() + WS_WOUT); }
    __device__ __forceinline__ bf16* WSGU() const { return (bf16*)(wsp() + WS_WSGU); }
    __device__ __forceinline__ bf16* XB() const { return (bf16*)(wsp() + WS_XB); }
    __device__ __forceinline__ bf16* YMIX() const { return (bf16*)(wsp() + WS_YMIX); }
    __device__ __forceinline__ bf16* PROJ() const { return (bf16*)(wsp() + WS_PROJ); }
    __device__ __forceinline__ f32x2* ROPE() const { return (f32x2*)(wsp() + WS_ROPE); }
    __device__ __forceinline__ float* SSQP() const { return (float*)(wsp() + WS_SSQP); }
    __device__ __forceinline__ float* RSTD() const { return (float*)(wsp() + WS_RSTD); }
    __device__ __forceinline__ float* GLAU() const { return (float*)(wsp() + WS_GLAU); }
    __device__ __forceinline__ float* GLAA() const { return (float*)(wsp() + WS_GLAA); }
    __device__ __forceinline__ float* Y() const { return (float*)(wsp() + WS_Y); }
};
__device__ __forceinline__ float bf2f(unsigned short u) { return __uint_as_float((unsigned)u << 16); }
__device__ __forceinline__ float bflo(unsigned u) { return __uint_as_float(u << 16); }
__device__ __forceinline__ float bfhi(unsigned u) { return __uint_as_float(u & 0xffff0000u); }
__device__ __forceinline__ float silu_f(float x) { return x / (1.f + __expf(-x)); }
__device__ __forceinline__ float wave_sum(float v) {
#pragma unroll
    for (int o = 1; o < 64; o <<= 1) v += __shfl_xor(v, o);
    return v;
}

__device__ __forceinline__ void p0_win_item(Frame& F, int l, int kb, int nb, LAS float* scr) {
    const int lane = F.lane, k0 = 64 * kb, n0 = 32 * nb, c = lane & 7;
    bf16* WT = F.Win_t() + (size_t)l * NP * D;
    if (nb >= C_END / 32) {
#pragma unroll
        for (int j = 0; j < 4; ++j) { const int n = (lane >> 3) + 8 * j; *(GAS v4u*)(WT + (size_t)(n0 + n) * D + k0 + 8 * c) = (v4u){0u, 0u, 0u, 0u}; }
        return;
    }
    const float* W = F.w_in() + (size_t)l * D * D_IN; const float* g = F.pre_g() + l * D;
    const int n = lane & 31;
    if (nb >= C_GLG / 32 && nb < C_GZ / 32) {
        const float* wg2 = F.gla_wg2() + l * 16 * 128 + (n0 - C_GLG + n);
        float w2[16];
#pragma unroll
        for (int r = 0; r < 16; ++r) w2[r] = wg2[r * 128];
#pragma unroll 4
        for (int i = 0; i < 32; ++i) { const int kk = 2 * i + (lane >> 5); const float* wr = W + (size_t)(k0 + kk) * D_IN + S_GLR; float a = 0.f;
#pragma unroll
            for (int r = 0; r < 16; ++r) a += wr[r] * w2[r];
            scr[kk * 33 + n] = a * g[k0 + kk]; }
    } else {
        const int sn0 = (nb < C_GLG / 32) ? n0 : n0 - 112;
        int sc = sn0 + n;
        if (n0 >= C_SQ && n0 < C_SV) { const int p = (n0 + n - C_SQ) & 63, j = p >> 3, e = p & 7; sc = sc - p + ((e < 4) ? 4 * j + e : 32 + 4 * j + (e - 4)); }
#pragma unroll 8
        for (int i = 0; i < 32; ++i) { const int kk = 2 * i + (lane >> 5); scr[kk * 33 + n] = W[(size_t)(k0 + kk) * D_IN + sc] * g[k0 + kk]; }
    }
    LDS_WAIT(); asm volatile("" ::: "memory");
#pragma unroll
    for (int j = 0; j < 4; ++j) { const int nn = (lane >> 3) + 8 * j; const LAS float* s = scr + (8 * c) * 33 + nn;
        v4u o; o.x = pk2(s[0 * 33], s[1 * 33]); o.y = pk2(s[2 * 33], s[3 * 33]); o.z = pk2(s[4 * 33], s[5 * 33]); o.w = pk2(s[6 * 33], s[7 * 33]);
        *(GAS v4u*)(WT + (size_t)(n0 + nn) * D + k0 + 8 * c) = o; }
    LDS_WAIT(); asm volatile("" ::: "memory");
}
__device__ __forceinline__ void p0_transpose_item(const float* W, int K, int N, bf16* WT, LAS float* scr, int item, int lane) {
    const int nblk = N / 32, kb = item / nblk, nb = item % nblk, k0 = 64 * kb, n0 = 32 * nb;
#pragma unroll 8
    for (int i = 0; i < 32; ++i) { const int kk = 2 * i + (lane >> 5); scr[kk * 33 + (lane & 31)] = W[(size_t)(k0 + kk) * N + n0 + (lane & 31)]; }
    LDS_WAIT(); asm volatile("" ::: "memory");
    const int c = lane & 7;
#pragma unroll
    for (int j = 0; j < 4; ++j) { const int n = (lane >> 3) + 8 * j; const LAS float* s = scr + (8 * c) * 33 + n;
        v4u o; o.x = pk2(s[0 * 33], s[1 * 33]); o.y = pk2(s[2 * 33], s[3 * 33]); o.z = pk2(s[4 * 33], s[5 * 33]); o.w = pk2(s[6 * 33], s[7 * 33]);
        *(GAS v4u*)(WT + (size_t)(n0 + n) * K + k0 + 8 * c) = o; }
    LDS_WAIT(); asm volatile("" ::: "memory");
}
__device__ __forceinline__ void p0_prologue(Frame& F) {
    { int t_ = threadIdx.x; asm volatile("" : "+v"(t_)); F.tid = t_; F.lane = t_ & 63; F.wave = __builtin_amdgcn_readfirstlane(t_ >> 6); }
    LAS float* scr = (LAS float*)(F.lds + F.wave * 16384);
    const int gw = F.vcu * NWAVES + F.wave, NGW = F.G * NWAVES;
    constexpr int I_IN = (D / 64) * (NP / 32), I_OUT = (D / 64) * (D / 32);
    for (int it = gw; it < DEPTH * (I_IN + I_OUT); it += NGW) {
        if (it < DEPTH * I_IN) { const int l = it / I_IN, r = it % I_IN; p0_win_item(F, l, r / (NP / 32), r % (NP / 32), scr); }
        else { const int r2 = it - DEPTH * I_IN, l = r2 / I_OUT, r = r2 % I_OUT; p0_transpose_item(F.w_out() + (size_t)l * D * D, D, D, F.Wout_t() + (size_t)l * D * D, scr, r, F.lane); }
    }
    for (int m = gw; m < M; m += NGW) {
        const GAS f32x4* xr = (const GAS f32x4*)(F.x() + (size_t)m * D) + F.lane;
        f32x4 v[4]; float s = 0.f;
#pragma unroll
        for (int j = 0; j < 4; ++j) { v[j] = xr[64 * j]; s += (v[j].x * v[j].x + v[j].y * v[j].y) + (v[j].z * v[j].z + v[j].w * v[j].w); }
        s = wave_sum(s);
        if (F.lane == 0) F.RSTD()[m] = 1.f / sqrtf(s * (1.f / D) + EPS);
        GAS unsigned long long* o8 = (GAS unsigned long long*)(F.XB() + (size_t)m * D) + F.lane;
#pragma unroll
        for (int j = 0; j < 4; ++j) o8[64 * j] = (unsigned long long)pk2(v[j].x, v[j].y) | ((unsigned long long)pk2(v[j].z, v[j].w) << 32);
    }
    for (int e = (gw * 64 + F.lane) * 4; e < DEPTH * 4 * 128 * 128; e += NGW * 64 * 4) { const f32x4 w = *(const GAS f32x4*)(F.gm_ws() + e); const int tt = (e >> 7) & 127, cc = e & 127;
        v2u o; o.x = pk2(cc <= tt ? w.x : 0.f, cc + 1 <= tt ? w.y : 0.f); o.y = pk2(cc + 2 <= tt ? w.z : 0.f, cc + 3 <= tt ? w.w : 0.f); *(GAS v2u*)(F.WSGU() + e) = o; }
    {
        const int i = F.lane & 31; const float inv = powf(10000.0f, -(float)i * 2.0f / 64.0f);
        for (int t = gw * 2; t < M; t += NGW * 2) { const int tok = t + (F.lane >> 5); const float ang = (float)F.positions()[tok] * inv; float sn, cs; sincosf(ang, &sn, &cs); F.ROPE()[(size_t)tok * 32 + i] = (f32x2){cs, sn}; }
    }
}

__device__ __forceinline__ void sgu_naive(Frame& F, int l) {
    { int t_ = threadIdx.x; asm volatile("" : "+v"(t_)); F.tid = t_; F.lane = t_ & 63; F.wave = __builtin_amdgcn_readfirstlane(t_ >> 6); }
    float* Vn = F.ldsf;
    const float* lng = F.gm_ln_g() + l * 256; const float* lnb = F.gm_ln_b() + l * 256;
    const float* ws = F.gm_ws() + (size_t)l * 4 * 128 * 128; const float* bs = F.gm_bs() + l * 4 * 128;
    for (int u = blockIdx.x; u < 512; u += F.G) {
        const int c = u >> 2, h = u & 3, r0 = c * 128;
        for (int i = 0; i < 16; ++i) { const int t = F.wave * 16 + i; const bf16* p = F.PROJ() + (size_t)(r0 + t) * NP + C_GMV + F.lane * 4;
            const uint2 raw = *(const uint2*)p; const float v0 = bflo(raw.x), v1 = bfhi(raw.x), v2 = bflo(raw.y), v3 = bfhi(raw.y);
            const float mean = wave_sum((v0 + v1) + (v2 + v3)) * (1.f / 256.f);
            const float d0 = v0 - mean, d1 = v1 - mean, d2 = v2 - mean, d3 = v3 - mean;
            const float var = wave_sum((d0 * d0 + d1 * d1) + (d2 * d2 + d3 * d3)) * (1.f / 256.f);
            const float rs = 1.f / sqrtf(var + EPS);
            if ((F.lane >> 4) == h) { const int cc = F.lane * 4, dd = cc - h * 64; float* o = Vn + t * 64 + dd;
                o[0] = d0 * rs * lng[cc] + lnb[cc]; o[1] = d1 * rs * lng[cc + 1] + lnb[cc + 1]; o[2] = d2 * rs * lng[cc + 2] + lnb[cc + 2]; o[3] = d3 * rs * lng[cc + 3] + lnb[cc + 3]; }
        }
        __syncthreads();
        const int d = F.tid & 63, tg = F.wave;
        for (int i = 0; i < 16; ++i) { const int t = tg + 8 * i; const float* wrow = ws + ((size_t)h * 128 + t) * 128; float a = 0.f;
            for (int c2 = 0; c2 <= t; ++c2) a += wrow[c2] * Vn[c2 * 64 + d];
            const float sv = a + bs[h * 128 + t];
            const bf16* pr = F.PROJ() + (size_t)(r0 + t) * NP; const float uu = bf2f(pr[C_GMU + h * 64 + d]), zz = bf2f(pr[C_GMZ + h * 64 + d]);
            F.YMIX()[(size_t)(r0 + t) * D + h * 64 + d] = (bf16)f2bf(uu * sv * silu_f(zz)); }
        __syncthreads();
    }
}
constexpr int GL_G = 0, GL_K = 128 * 33, GL_Q = 2 * 128 * 33, GL_V = 3 * 128 * 33, GL_S = GL_V + 128 * 64, GL_SCR = GL_S + 32 * 64;
__device__ __forceinline__ void gla_load(Frame& F, int l, int seq, int blk, bool want_q) {
    float* Gs = F.ldsf + GL_G; float* Ks = F.ldsf + GL_K; float* Qs = F.ldsf + GL_Q; float* Vs = F.ldsf + GL_V;
    const int b = seq >> 2, h = seq & 3, r0 = b * SEQ + blk * 128;
    const float* bg = F.gla_bg() + l * 128 + h * 32;
    { const int k = F.tid & 31, tq = F.tid >> 5;
        for (int i = 0; i < 8; ++i) { const int t = tq + 16 * i; const bf16* pr = F.PROJ() + (size_t)(r0 + t) * NP;
            const float xl = bf2f(pr[C_GLG + h * 32 + k]) + bg[k];
            const float ls = fminf(xl, 0.f) - log1pf(expf(-fabsf(xl)));
            Gs[t * 33 + k] = ls * (1.f / 16.f);
            Ks[t * 33 + k] = bf2f(pr[C_GK + h * 32 + k]);
            if (want_q) Qs[t * 33 + k] = bf2f(pr[C_GQ + h * 32 + k]) * 0.17677669529663687f; } }
    { const int v = F.tid & 63, tg = F.tid >> 6;
        for (int i = 0; i < 16; ++i) { const int t = tg + 8 * i; Vs[t * 64 + v] = bf2f(F.PROJ()[(size_t)(r0 + t) * NP + C_GV + h * 64 + v]); } }
    __syncthreads();
    if (F.tid < 32) { float run = 0.f; for (int t = 0; t < 128; ++t) { run += Gs[t * 33 + F.tid]; Gs[t * 33 + F.tid] = run; } }
    __syncthreads();
}
__device__ __forceinline__ void gla_summ_naive(Frame& F, int l) {
    { int t_ = threadIdx.x; asm volatile("" : "+v"(t_)); F.tid = t_; F.lane = t_ & 63; F.wave = __builtin_amdgcn_readfirstlane(t_ >> 6); }
    float* Gs = F.ldsf + GL_G; float* Ks = F.ldsf + GL_K; float* Vs = F.ldsf + GL_V;
    for (int u = blockIdx.x; u < 512; u += F.G) {
        const int seq = u >> 6, blk = u & 63;
        gla_load(F, l, seq, blk, false);
        const int v = F.tid & 63, kq = F.wave;
        float acc[4] = {0.f, 0.f, 0.f, 0.f}, ge[4];
#pragma unroll
        for (int j = 0; j < 4; ++j) ge[j] = Gs[127 * 33 + kq + 8 * j];
        for (int s = 0; s < 128; ++s) { const float vv = Vs[s * 64 + v];
#pragma unroll
            for (int j = 0; j < 4; ++j) { const int k = kq + 8 * j; acc[j] += Ks[s * 33 + k] * __expf(ge[j] - Gs[s * 33 + k]) * vv; } }
        float* U = F.GLAU() + (size_t)(seq * 64 + blk) * 2048;
#pragma unroll
        for (int j = 0; j < 4; ++j) U[(kq + 8 * j) * 64 + v] = acc[j];
        if (F.tid < 32) F.GLAA()[(seq * 64 + blk) * 32 + F.tid] = __expf(Gs[127 * 33 + F.tid]);
        __syncthreads();
    }
}
__device__ __forceinline__ void gla_out_naive(Frame& F, int l) {
    { int t_ = threadIdx.x; asm volatile("" : "+v"(t_)); F.tid = t_; F.lane = t_ & 63; F.wave = __builtin_amdgcn_readfirstlane(t_ >> 6); }
    float* Gs = F.ldsf + GL_G; float* Ks = F.ldsf + GL_K; float* Qs = F.ldsf + GL_Q; float* Vs = F.ldsf + GL_V; float* Sin = F.ldsf + GL_S; float* scw = F.ldsf + GL_SCR + F.wave * 128;
    const float* ng = F.gla_norm_g() + l * 64;
    for (int u = blockIdx.x; u < 512; u += F.G) {
        const int seq = u >> 6, blk = u & 63, b = seq >> 2, h = seq & 3, r0 = b * SEQ + blk * 128;
        { float s[4] = {0.f, 0.f, 0.f, 0.f}; const float* Ub = F.GLAU() + (size_t)seq * 64 * 2048; const float* Ab = F.GLAA() + seq * 64 * 32;
            for (int i = 0; i < blk; ++i) {
#pragma unroll
                for (int j = 0; j < 4; ++j) { const int e = F.tid + 512 * j; s[j] = Ab[i * 32 + (e >> 6)] * s[j] + Ub[(size_t)i * 2048 + e]; } }
#pragma unroll
            for (int j = 0; j < 4; ++j) Sin[F.tid + 512 * j] = s[j]; }
        gla_load(F, l, seq, blk, true);
        const int v = F.lane, w = F.wave;
        for (int i = 0; i < 16; ++i) { const int t = w + 8 * i;
#pragma unroll
            for (int half = 0; half < 2; ++half) { const int s_ = F.lane + 64 * half; float a = 0.f;
                if (s_ <= t) { for (int k = 0; k < 32; ++k) a += Qs[t * 33 + k] * Ks[s_ * 33 + k] * __expf(Gs[t * 33 + k] - Gs[s_ * 33 + k]); }
                scw[s_] = a; }
            float o = 0.f;
            for (int s_ = 0; s_ <= t; ++s_) o += scw[s_] * Vs[s_ * 64 + v];
            for (int k = 0; k < 32; ++k) o += Qs[t * 33 + k] * __expf(Gs[t * 33 + k]) * Sin[k * 64 + v];
            const float ms = wave_sum(o * o) * (1.f / 64.f); const float on = o * (1.f / sqrtf(ms + EPS)) * ng[v];
            const float z = bf2f(F.PROJ()[(size_t)(r0 + t) * NP + C_GZ + h * 64 + v]);
            F.YMIX()[(size_t)(r0 + t) * D + 256 + h * 64 + v] = (bf16)f2bf(on * silu_f(z)); }
        __syncthreads();
    }
}
__device__ __forceinline__ void swa_naive(Frame& F, int l) {
    { int t_ = threadIdx.x; asm volatile("" : "+v"(t_)); F.tid = t_; F.lane = t_ & 63; F.wave = __builtin_amdgcn_readfirstlane(t_ >> 6); }
    float* Kf = F.ldsf; float* Vf = F.ldsf + 256 * 65;
    for (int u = blockIdx.x; u < 256; u += F.G) {
        const int hk = u & 1, n = (u >> 1) & 63, b = u >> 7;
        const int rq0 = b * SEQ + n * 128, rk0 = rq0 - 128;
        for (int idx = F.tid; idx < 256 * 32; idx += 512) { const int j = idx >> 5, dp = idx & 31; float k1 = 0.f, k2 = 0.f, v1 = 0.f, v2 = 0.f;
            if (n > 0 || j >= 128) { const size_t r = (size_t)(rk0 + j); const bf16* pr = F.PROJ() + r * NP;
                k1 = bf2f(pr[C_SK + hk * 64 + dp]); k2 = bf2f(pr[C_SK + hk * 64 + dp + 32]); v1 = bf2f(pr[C_SV + hk * 64 + dp]); v2 = bf2f(pr[C_SV + hk * 64 + dp + 32]); }
            Kf[j * 65 + dp] = k1; Kf[j * 65 + dp + 32] = k2; Vf[j * 64 + dp] = v1; Vf[j * 64 + dp + 32] = v2; }
        __syncthreads();
        const int i = F.tid >> 2, part = F.tid & 3; const size_t rq = (size_t)(rq0 + i);
        for (int g = 0; g < 4; ++g) { const int qh = hk * 4 + g;
            float q[64];
            { const bf16* pr = F.PROJ() + rq * NP + C_SQ + qh * 64;
#pragma unroll
                for (int d = 0; d < 64; ++d) q[d] = bf2f(pr[d]); }
            const float sink = F.swa_sinks()[l * 8 + qh] * 1.4426950408889634f;
            float mx = sink, lsum = (part == 0) ? 1.f : 0.f; float o[64];
#pragma unroll
            for (int d = 0; d < 64; ++d) o[d] = 0.f;
            for (int jj = 0; jj < 64; ++jj) { const int key = 4 * jj + part; const bool valid = (key > i) && (key <= i + 128) && (n > 0 || key >= 128);
                if (valid) { const float* kr = Kf + key * 65; float s = 0.f;
#pragma unroll
                    for (int d = 0; d < 64; ++d) s += q[d] * kr[d];
                    const float mn = fmaxf(mx, s), sc_ = exp2f(mx - mn), p = exp2f(s - mn); lsum = lsum * sc_ + p; const float* vr = Vf + key * 64;
#pragma unroll
                    for (int d = 0; d < 64; ++d) o[d] = o[d] * sc_ + p * vr[d];
                    mx = mn; } }
            float mt = fmaxf(mx, __shfl_xor(mx, 1)); mt = fmaxf(mt, __shfl_xor(mt, 2)); const float f = exp2f(mx - mt);
            lsum *= f; lsum += __shfl_xor(lsum, 1); lsum += __shfl_xor(lsum, 2); const float inv = 1.f / lsum;
            const bf16* pz = F.PROJ() + rq * NP + C_SZ + qh * 64; bf16* py = F.YMIX() + rq * D + 512 + qh * 64;
#pragma unroll
            for (int d = 0; d < 64; ++d) { float xx = o[d] * f; xx += __shfl_xor(xx, 1); xx += __shfl_xor(xx, 2); xx *= inv;
                if ((d >> 4) == part) py[d] = (bf16)f2bf(xx * silu_f(bf2f(pz[d]))); }
        }
        __syncthreads();
    }
}

typedef short s16x4 __attribute__((ext_vector_type(4)));
typedef float f32x16 __attribute__((ext_vector_type(16)));
typedef float f32x2_t __attribute__((ext_vector_type(2))); typedef __bf16 bf16x2_t __attribute__((ext_vector_type(2)));
#define MFMA32(a, b, c) __builtin_amdgcn_mfma_f32_32x32x16_bf16(a, b, c, 0, 0, 0)
__device__ __forceinline__ unsigned cvtpk(float lo, float hi) { f32x2_t v = {lo, hi}; bf16x2_t b = __builtin_convertvector(v, bf16x2_t); return __builtin_bit_cast(unsigned, b); }
__device__ __forceinline__ bf16x8 acc_frag(const f32x16& x, int s) {
    v4u w; w.x = cvtpk(x[8 * s + 0], x[8 * s + 1]); w.y = cvtpk(x[8 * s + 2], x[8 * s + 3]); w.z = cvtpk(x[8 * s + 4], x[8 * s + 5]); w.w = cvtpk(x[8 * s + 6], x[8 * s + 7]);
    return __builtin_bit_cast(bf16x8, w);
}
template <bool PERMUTED> __device__ __forceinline__ bf16x8 tr_frag(LAS const unsigned char* base, int stride, int lane) {
    const int q = (lane & 15) >> 2, p = lane & 3, ch = (lane >> 4) & 1, h = lane >> 5;
    const int row0 = PERMUTED ? 4 * h + q : 8 * h + q;
    LAS const unsigned char* a0 = base + row0 * stride + (16 * ch + 4 * p) * 2;
    const s16x4 r0 = __builtin_amdgcn_ds_read_tr16_b64_v4i16((LAS s16x4*)a0);
    const s16x4 r1 = __builtin_amdgcn_ds_read_tr16_b64_v4i16((LAS s16x4*)(a0 + (PERMUTED ? 8 : 4) * stride));
    return (bf16x8){r0[0], r0[1], r0[2], r0[3], r1[0], r1[1], r1[2], r1[3]};
}
__device__ __forceinline__ float fast_exp2(float x) { return __builtin_amdgcn_exp2f(x); }

__device__ __forceinline__ void swa_mfma(Frame& F, int l) {
    { int t_ = threadIdx.x; asm volatile("" : "+v"(t_)); F.tid = t_; F.lane = t_ & 63; F.wave = __builtin_amdgcn_readfirstlane(t_ >> 6); }
    LAS unsigned char* Kl = F.lds; LAS unsigned char* Vl = F.lds + 32768;
    const int lane = F.lane, q = lane & 31, h = lane >> 5, i4 = F.wave & 3;
    for (int u = blockIdx.x; u < 256; u += F.G) {
        const int hk = u & 1, n = (u >> 1) & 63, b = u >> 7;
        const int rq0 = b * SEQ + n * 128, rk0 = rq0 - 128;
#pragma unroll
        for (int i = 0; i < 4; ++i) { const int c = F.tid + 512 * i, row = c >> 3, ch = c & 7; v4u kv = {0u, 0u, 0u, 0u}, vv = {0u, 0u, 0u, 0u};
            if (n > 0 || row >= 128) { const bf16* pr = F.PROJ() + (size_t)(rk0 + row) * NP; kv = *(const GAS v4u*)(pr + C_SK + hk * 64 + ch * 8); vv = *(const GAS v4u*)(pr + C_SV + hk * 64 + ch * 8); }
            *(LAS v4u*)(Kl + row * 128 + ((ch ^ (row & 7)) << 4)) = kv; *(LAS v4u*)(Vl + row * 128 + ch * 16) = vv; }
        __syncthreads();
        const size_t rq = (size_t)(rq0 + 32 * i4 + q);
#pragma unroll 1
        for (int gg = 0; gg < 2; ++gg) { const int qh = hk * 4 + 2 * (F.wave >> 2) + gg;
            bf16x8 qf[4];
#pragma unroll
            for (int s = 0; s < 4; ++s) qf[s] = *(const GAS bf16x8*)(F.PROJ() + rq * NP + C_SQ + qh * 64 + 16 * s + 8 * h);
            f32x16 S[5];
#pragma unroll
            for (int tt = 0; tt < 5; ++tt) { const int kt = i4 + tt; const bool act = (n > 0) || (kt >= 4);
                f32x16 acc;
#pragma unroll
                for (int r = 0; r < 16; ++r) acc[r] = 0.f;
                if (act) { const int krow = 32 * kt + q;
#pragma unroll
                    for (int s = 0; s < 4; ++s) { const bf16x8 kf = *(const LAS bf16x8*)(Kl + krow * 128 + (((2 * s + h) ^ (krow & 7)) << 4)); acc = MFMA32(kf, qf[s], acc); } }
#pragma unroll
                for (int r = 0; r < 16; ++r) { const int kk = (r & 3) + 8 * (r >> 2) + 4 * h; bool ok = act; if (tt == 0) ok = ok && (kk > q); if (tt == 4) ok = ok && (kk <= q); S[tt][r] = ok ? acc[r] : -INFINITY; } }
            const float sink = F.swa_sinks()[l * 8 + qh] * LOG2E;
            float mx = sink;
#pragma unroll
            for (int tt = 0; tt < 5; ++tt)
#pragma unroll
                for (int r = 0; r < 16; ++r) mx = fmaxf(mx, S[tt][r]);
            mx = fmaxf(mx, __shfl_xor(mx, 32));
            float sum = 0.f;
#pragma unroll
            for (int tt = 0; tt < 5; ++tt)
#pragma unroll
                for (int r = 0; r < 16; ++r) { const float p = fast_exp2(S[tt][r] - mx); S[tt][r] = p; sum += p; }
            sum += __shfl_xor(sum, 32); sum += fast_exp2(sink - mx);
            const float inv = 1.f / sum;
            f32x16 O[2];
#pragma unroll
            for (int r = 0; r < 16; ++r) { O[0][r] = 0.f; O[1][r] = 0.f; }
#pragma unroll
            for (int tt = 0; tt < 5; ++tt) { const int kt = i4 + tt; const bool act = (n > 0) || (kt >= 4);
                if (act) {
#pragma unroll
                    for (int s = 0; s < 2; ++s) { const bf16x8 pf = acc_frag(S[tt], s);
#pragma unroll
                        for (int dt = 0; dt < 2; ++dt) { const bf16x8 vf = tr_frag<true>(Vl + (32 * kt + 16 * s) * 128 + dt * 64, 128, lane); O[dt] = MFMA32(vf, pf, O[dt]); } } } }
            const bf16* pz = F.PROJ() + rq * NP + C_SZ + qh * 64; bf16* py = F.YMIX() + rq * D + 512 + qh * 64;
#pragma unroll
            for (int dt = 0; dt < 2; ++dt)
#pragma unroll
                for (int g4 = 0; g4 < 4; ++g4) { const int d0 = 32 * dt + 8 * g4 + 4 * h; const v2u z = *(const GAS v2u*)(pz + d0);
                    const float o0 = O[dt][4 * g4 + 0] * inv * silu_f(bflo(z.x)), o1 = O[dt][4 * g4 + 1] * inv * silu_f(bfhi(z.x)), o2 = O[dt][4 * g4 + 2] * inv * silu_f(bflo(z.y)), o3 = O[dt][4 * g4 + 3] * inv * silu_f(bfhi(z.y));
                    v2u w; w.x = cvtpk(o0, o1); w.y = cvtpk(o2, o3); *(GAS v2u*)(py + d0) = w; }
        }
        __syncthreads();
    }
}

__device__ __forceinline__ void sgu_mfma(Frame& F, int l) {
    { int t_ = threadIdx.x; asm volatile("" : "+v"(t_)); F.tid = t_; F.lane = t_ & 63; F.wave = __builtin_amdgcn_readfirstlane(t_ >> 6); }
    LAS unsigned char* Vn = F.lds;
    const int lane = F.lane, hh = lane >> 5;
    const float* lng = F.gm_ln_g() + l * 256; const float* lnb = F.gm_ln_b() + l * 256;
    for (int u = blockIdx.x; u < 128; u += F.G) {
        const int r0 = u * 128;
        { const f32x4 g4v = *(const GAS f32x4*)(lng + 4 * lane), b4v = *(const GAS f32x4*)(lnb + 4 * lane);
#pragma unroll 4
            for (int i = 0; i < 16; ++i) { const int t = F.wave * 16 + i; const v2u raw = *(const GAS v2u*)(F.PROJ() + (size_t)(r0 + t) * NP + C_GMV + lane * 4);
                const float v0 = bflo(raw.x), v1 = bfhi(raw.x), v2 = bflo(raw.y), v3 = bfhi(raw.y);
                const float mean = wave_sum((v0 + v1) + (v2 + v3)) * (1.f / 256.f);
                const float d0 = v0 - mean, d1 = v1 - mean, d2 = v2 - mean, d3 = v3 - mean;
                const float var = wave_sum((d0 * d0 + d1 * d1) + (d2 * d2 + d3 * d3)) * (1.f / 256.f);
                const float rs = 1.f / sqrtf(var + EPS);
                v2u w; w.x = cvtpk(d0 * rs * g4v[0] + b4v[0], d1 * rs * g4v[1] + b4v[1]); w.y = cvtpk(d2 * rs * g4v[2] + b4v[2], d3 * rs * g4v[3] + b4v[3]);
                *(LAS v2u*)(Vn + t * 512 + lane * 8) = w; } }
        __syncthreads();
        const int hd = F.wave >> 1;
#pragma unroll 1
        for (int tsel = 0; tsel < 2; ++tsel) { const int tb = (F.wave & 1) ? (1 + tsel) : (3 * tsel); const int trow = 32 * tb + (lane & 31);
            f32x16 acc[2];
#pragma unroll
            for (int r = 0; r < 16; ++r) { acc[0][r] = 0.f; acc[1][r] = 0.f; }
            const bf16* wrow = F.WSGU() + ((size_t)(l * 4 + hd) * 128 + trow) * 128 + 8 * hh;
            for (int ks = 0; ks < 2 * (tb + 1); ++ks) { const bf16x8 wf = *(const GAS bf16x8*)(wrow + 16 * ks);
#pragma unroll
                for (int dt = 0; dt < 2; ++dt) { const bf16x8 vf = tr_frag<false>(Vn + (16 * ks) * 512 + (hd * 64 + 32 * dt) * 2, 512, lane); acc[dt] = MFMA32(vf, wf, acc[dt]); } }
            const size_t row = (size_t)(r0 + trow); const float bsv = F.gm_bs()[l * 512 + hd * 128 + trow];
            const bf16* pr = F.PROJ() + row * NP + hd * 64; bf16* py = F.YMIX() + row * D + hd * 64;
#pragma unroll
            for (int dt = 0; dt < 2; ++dt)
#pragma unroll
                for (int g4 = 0; g4 < 4; ++g4) { const int d0 = 32 * dt + 8 * g4 + 4 * hh; const v2u uu = *(const GAS v2u*)(pr + C_GMU + d0), zz = *(const GAS v2u*)(pr + C_GMZ + d0);
                    const float o0 = bflo(uu.x) * (acc[dt][4 * g4 + 0] + bsv) * silu_f(bflo(zz.x)), o1 = bfhi(uu.x) * (acc[dt][4 * g4 + 1] + bsv) * silu_f(bfhi(zz.x));
                    const float o2 = bflo(uu.y) * (acc[dt][4 * g4 + 2] + bsv) * silu_f(bflo(zz.y)), o3 = bfhi(uu.y) * (acc[dt][4 * g4 + 3] + bsv) * silu_f(bfhi(zz.y));
                    v2u w; w.x = cvtpk(o0, o1); w.y = cvtpk(o2, o3); *(GAS v2u*)(py + d0) = w; }
        }
        __syncthreads();
    }
}

constexpr size_t GLA_U_FLOATS = 2048;
template <bool OUT> __device__ __forceinline__ void gla_unit(Frame& F, int l, int seq, int blk, LAS unsigned char* wl, int lane) {
    const int t = lane & 31, h = lane >> 5, b = seq >> 2, hd = seq & 3, r0 = b * SEQ + blk * 128;
    LAS unsigned char* KD = wl; LAS unsigned char* VV = wl + 2048;
    f32x16 S[2];
#pragma unroll
    for (int r = 0; r < 16; ++r) { S[0][r] = 0.f; S[1][r] = 0.f; }
    float gsum[16];
#pragma unroll
    for (int r = 0; r < 16; ++r) gsum[r] = 0.f;
    if (OUT) {
        const float* Ub = F.GLAU() + (size_t)seq * 64 * GLA_U_FLOATS + lane * 4; const float* Ab = F.GLAA() + seq * 64 * 32 + h * 16;
        for (int i = 0; i < blk; ++i) {
            f32x4 uv[2][4], av[4];
#pragma unroll
            for (int vt = 0; vt < 2; ++vt)
#pragma unroll
                for (int g4 = 0; g4 < 4; ++g4) uv[vt][g4] = *(const GAS f32x4*)(Ub + (size_t)i * GLA_U_FLOATS + (vt * 4 + g4) * 256);
#pragma unroll
            for (int g4 = 0; g4 < 4; ++g4) av[g4] = *(const GAS f32x4*)(Ab + i * 32 + 4 * g4);
#pragma unroll
            for (int vt = 0; vt < 2; ++vt)
#pragma unroll
                for (int r = 0; r < 16; ++r) S[vt][r] = av[r >> 2][r & 3] * S[vt][r] + uv[vt][r >> 2][r & 3];
        }
    }
    float bgv[16];
    { const float* bg = F.gla_bg() + l * 128 + hd * 32;
#pragma unroll
        for (int r = 0; r < 16; ++r) bgv[r] = bg[(r & 3) + 8 * (r >> 2) + 4 * h]; }
    float ngv[2][16];
    if (OUT) { const float* ng = F.gla_norm_g() + l * 64;
#pragma unroll
        for (int vt = 0; vt < 2; ++vt)
#pragma unroll
            for (int r = 0; r < 16; ++r) ngv[vt][r] = ng[32 * vt + (r & 3) + 8 * (r >> 2) + 4 * h]; }
#pragma unroll 1
    for (int c = 0; c < 4; ++c) {
        const size_t row = (size_t)(r0 + 32 * c + t); const bf16* pr = F.PROJ() + row * NP;
        float G[16], kk[16], qq[16];
#pragma unroll
        for (int g4 = 0; g4 < 4; ++g4) { const int k0 = hd * 32 + 8 * g4 + 4 * h;
            const v2u lg = *(const GAS v2u*)(pr + C_GLG + k0), kr = *(const GAS v2u*)(pr + C_GK + k0);
            G[4 * g4 + 0] = bflo(lg.x); G[4 * g4 + 1] = bfhi(lg.x); G[4 * g4 + 2] = bflo(lg.y); G[4 * g4 + 3] = bfhi(lg.y);
            kk[4 * g4 + 0] = bflo(kr.x); kk[4 * g4 + 1] = bfhi(kr.x); kk[4 * g4 + 2] = bflo(kr.y); kk[4 * g4 + 3] = bfhi(kr.y);
            if (OUT) { const v2u qr = *(const GAS v2u*)(pr + C_GQ + k0); qq[4 * g4 + 0] = bflo(qr.x); qq[4 * g4 + 1] = bfhi(qr.x); qq[4 * g4 + 2] = bflo(qr.y); qq[4 * g4 + 3] = bfhi(qr.y); } }
        { const GAS v4u* pv = (const GAS v4u*)(pr + C_GV + hd * 64 + 32 * h);
#pragma unroll
            for (int i = 0; i < 4; ++i) *(LAS v4u*)(VV + t * 128 + h * 64 + i * 16) = pv[i]; }
        float Ge[16];
#pragma unroll
        for (int r = 0; r < 16; ++r) { const float xl = G[r] + bgv[r]; float x = (fminf(xl, 0.f) - __logf(1.f + __expf(-fabsf(xl)))) * (1.f / 16.f);
#pragma unroll
            for (int d = 1; d < 32; d <<= 1) { const float y = __shfl_up(x, d, 32); x += (t >= d) ? y : 0.f; }
            G[r] = x; Ge[r] = __shfl(x, 31, 32); }
#pragma unroll
        for (int g4 = 0; g4 < 4; ++g4) { v2u w; w.x = cvtpk(kk[4 * g4 + 0] * __expf(Ge[4 * g4 + 0] - G[4 * g4 + 0]), kk[4 * g4 + 1] * __expf(Ge[4 * g4 + 1] - G[4 * g4 + 1]));
            w.y = cvtpk(kk[4 * g4 + 2] * __expf(Ge[4 * g4 + 2] - G[4 * g4 + 2]), kk[4 * g4 + 3] * __expf(Ge[4 * g4 + 3] - G[4 * g4 + 3]));
            *(LAS v2u*)(KD + t * 64 + (8 * g4 + 4 * h) * 2) = w; }
        asm volatile("" ::: "memory");
        bf16x8 vf[2][2], kdf[2];
#pragma unroll
        for (int st = 0; st < 2; ++st) { kdf[st] = tr_frag<true>(KD + (16 * st) * 64, 64, lane);
#pragma unroll
            for (int vt = 0; vt < 2; ++vt) vf[vt][st] = tr_frag<true>(VV + (16 * st) * 128 + vt * 64, 128, lane); }
        if (OUT) {
            float qt[16], kt[16];
#pragma unroll
            for (int r = 0; r < 16; ++r) { qt[r] = qq[r] * __expf(G[r]) * 0.17677669529663687f; kt[r] = kk[r] * __expf(-G[r]); }
            bf16x8 qf[2], kf[2];
#pragma unroll
            for (int st = 0; st < 2; ++st) { v4u a, bq;
                a.x = cvtpk(kt[8 * st + 0], kt[8 * st + 1]); a.y = cvtpk(kt[8 * st + 2], kt[8 * st + 3]); a.z = cvtpk(kt[8 * st + 4], kt[8 * st + 5]); a.w = cvtpk(kt[8 * st + 6], kt[8 * st + 7]);
                bq.x = cvtpk(qt[8 * st + 0], qt[8 * st + 1]); bq.y = cvtpk(qt[8 * st + 2], qt[8 * st + 3]); bq.z = cvtpk(qt[8 * st + 4], qt[8 * st + 5]); bq.w = cvtpk(qt[8 * st + 6], qt[8 * st + 7]);
                kf[st] = __builtin_bit_cast(bf16x8, a); qf[st] = __builtin_bit_cast(bf16x8, bq); }
            f32x16 at;
#pragma unroll
            for (int r = 0; r < 16; ++r) at[r] = 0.f;
            at = MFMA32(kf[0], qf[0], at); at = MFMA32(kf[1], qf[1], at);
#pragma unroll
            for (int r = 0; r < 16; ++r) { const int s_ = (r & 3) + 8 * (r >> 2) + 4 * h; at[r] = (s_ <= t) ? at[r] : 0.f; }
            f32x16 O[2]; float ss = 0.f;
#pragma unroll
            for (int vt = 0; vt < 2; ++vt) {
#pragma unroll
                for (int r = 0; r < 16; ++r) O[vt][r] = 0.f;
#pragma unroll
                for (int st = 0; st < 2; ++st) O[vt] = MFMA32(vf[vt][st], acc_frag(at, st), O[vt]);
#pragma unroll
                for (int st = 0; st < 2; ++st) O[vt] = MFMA32(acc_frag(S[vt], st), qf[st], O[vt]);
#pragma unroll
                for (int r = 0; r < 16; ++r) ss += O[vt][r] * O[vt][r]; }
            ss += __shfl_xor(ss, 32);
            const float rs = 1.f / sqrtf(ss * (1.f / 64.f) + EPS);
            const bf16* pz = pr + C_GZ + hd * 64; bf16* py = F.YMIX() + row * D + 256 + hd * 64;
#pragma unroll
            for (int vt = 0; vt < 2; ++vt)
#pragma unroll
                for (int g4 = 0; g4 < 4; ++g4) { const int v0 = 32 * vt + 8 * g4 + 4 * h; const v2u z = *(const GAS v2u*)(pz + v0);
                    const float o0 = O[vt][4 * g4 + 0] * rs * ngv[vt][4 * g4 + 0] * silu_f(bflo(z.x)), o1 = O[vt][4 * g4 + 1] * rs * ngv[vt][4 * g4 + 1] * silu_f(bfhi(z.x));
                    const float o2 = O[vt][4 * g4 + 2] * rs * ngv[vt][4 * g4 + 2] * silu_f(bflo(z.y)), o3 = O[vt][4 * g4 + 3] * rs * ngv[vt][4 * g4 + 3] * silu_f(bfhi(z.y));
                    v2u w; w.x = cvtpk(o0, o1); w.y = cvtpk(o2, o3); *(GAS v2u*)(py + v0) = w; }
        }
#pragma unroll
        for (int r = 0; r < 16; ++r) { const float a = __expf(Ge[r]); S[0][r] *= a; S[1][r] *= a; gsum[r] += Ge[r]; }
#pragma unroll
        for (int vt = 0; vt < 2; ++vt)
#pragma unroll
            for (int st = 0; st < 2; ++st) S[vt] = MFMA32(kdf[st], vf[vt][st], S[vt]);
        asm volatile("" ::: "memory");
    }
    if (!OUT) {
        float* U = F.GLAU() + (size_t)(seq * 64 + blk) * GLA_U_FLOATS + lane * 4;
#pragma unroll
        for (int vt = 0; vt < 2; ++vt)
#pragma unroll
            for (int g4 = 0; g4 < 4; ++g4) *(GAS f32x4*)(U + (vt * 4 + g4) * 256) = (f32x4){S[vt][4 * g4 + 0], S[vt][4 * g4 + 1], S[vt][4 * g4 + 2], S[vt][4 * g4 + 3]};
        if (t == 0) { float* A = F.GLAA() + (seq * 64 + blk) * 32 + h * 16;
#pragma unroll
            for (int g4 = 0; g4 < 4; ++g4) *(GAS f32x4*)(A + 4 * g4) = (f32x4){__expf(gsum[4 * g4 + 0]), __expf(gsum[4 * g4 + 1]), __expf(gsum[4 * g4 + 2]), __expf(gsum[4 * g4 + 3])}; }
    }
}
__device__ __forceinline__ void gla_summ_mfma(Frame& F, int l) {
    { int t_ = threadIdx.x; asm volatile("" : "+v"(t_)); F.tid = t_; F.lane = t_ & 63; F.wave = __builtin_amdgcn_readfirstlane(t_ >> 6); }
    const int first = (F.G >= 192) ? 128 : 0, nwg = (F.G >= 192) ? 64 : F.G;
    const int bx = (int)blockIdx.x - first;
    if (bx < 0 || bx >= nwg) return;
    for (int id = bx * NWAVES + F.wave; id < 512; id += nwg * NWAVES) gla_unit<false>(F, l, id >> 6, id & 63, F.lds + F.wave * 8192, F.lane);
}
__device__ __forceinline__ void gla_out_mfma(Frame& F, int l) {
    { int t_ = threadIdx.x; asm volatile("" : "+v"(t_)); F.tid = t_; F.lane = t_ & 63; F.wave = __builtin_amdgcn_readfirstlane(t_ >> 6); }
    for (int id = F.wave * F.G + (int)blockIdx.x; id < 512; id += NWAVES * F.G) gla_unit<true>(F, l, id >> 6, id & 63, F.lds + F.wave * 8192, F.lane);
}

__device__ __forceinline__ void resid_rows(Frame& F, int l) {
    { int t_ = threadIdx.x; asm volatile("" : "+v"(t_)); F.tid = t_; F.lane = t_ & 63; F.wave = __builtin_amdgcn_readfirstlane(t_ >> 6); }
    const int gw = F.vcu * NWAVES + F.wave, NGW = F.G * NWAVES;
    const float* xin = (l == 0) ? F.x() : F.outp(); const GAS f32x4* pg = (const GAS f32x4*)(F.post_g() + l * D) + F.lane;
    for (int m = gw; m < M; m += NGW) {
        float sy = (F.lane < 16) ? F.SSQP()[(size_t)m * 16 + F.lane] : 0.f; sy = wave_sum(sy);
        const float ry = 1.f / sqrtf(sy * (1.f / D) + EPS);
        const GAS f32x4* xr = (const GAS f32x4*)(xin + (size_t)m * D) + F.lane; const GAS f32x4* yr = (const GAS f32x4*)(F.Y() + (size_t)m * D) + F.lane;
        GAS f32x4* orow = (GAS f32x4*)(F.outp() + (size_t)m * D) + F.lane;
        f32x4 v[4]; float s = 0.f;
#pragma unroll
        for (int j = 0; j < 4; ++j) { v[j] = xr[64 * j] + yr[64 * j] * ry * pg[64 * j]; s += (v[j].x * v[j].x + v[j].y * v[j].y) + (v[j].z * v[j].z + v[j].w * v[j].w); orow[64 * j] = v[j]; }
        s = wave_sum(s);
        if (F.lane == 0) F.RSTD()[m] = 1.f / sqrtf(s * (1.f / D) + EPS);
        GAS unsigned long long* o8 = (GAS unsigned long long*)(F.XB() + (size_t)m * D) + F.lane;
#pragma unroll
        for (int j = 0; j < 4; ++j) o8[64 * j] = (unsigned long long)pk2(v[j].x, v[j].y) | ((unsigned long long)pk2(v[j].z, v[j].w) << 32);
    }
}

struct Args { const void* in[14]; float* out; unsigned char* ws; int ph_lo, ph_hi; };
__global__ void __launch_bounds__(NWAVES * 64, 2) hybrid_fwd(Args args) {
    extern __shared__ __attribute__((aligned(16))) unsigned char lds[];
    Frame F;
    F.lds = (LAS unsigned char*)lds; F.ldsf = (float*)lds;
    F.MISC = (volatile LAS unsigned*)(F.lds + MISC_OFF);
    F.tid = threadIdx.x; F.lane = F.tid & 63; F.wave = __builtin_amdgcn_readfirstlane(F.tid >> 6);
    F.G = gridDim.x; { const int bx = blockIdx.x; F.vcu = (F.G % 8 == 0) ? (bx % 8) * (F.G / 8) + bx / 8 : bx; }
    for (int u = F.tid; u < (LDS_BYTES - LDSCTL_OFF) / 4; u += NWAVES * 64) ((LAS unsigned*)(F.lds + LDSCTL_OFF))[u] = 0u;
    __syncthreads();
    if (MK_ONE_LAUNCH) (void)xcd_barrier_post((unsigned*)(F.ctl() + CW_BAR), F.MISC + 8);
#define PH_LO (((const volatile int __attribute__((address_space(4)))*)__builtin_amdgcn_kernarg_segment_ptr())[32])
#define PH_HI (((const volatile int __attribute__((address_space(4)))*)__builtin_amdgcn_kernarg_segment_ptr())[33])
#define IN(k) (PH_LO <= (k) && (k) < PH_HI)
#define SEAM(k) do { if (IN(k) && IN((k) + 1)) { XcdBarrier bar_; bar_.bar = (unsigned*)(F.ctl() + CW_BAR); bar_.x = xb_xcc_id(); bar_.st = F.MISC + 8; xcd_barrier(bar_); } } while (0)

    if (IN(0)) { p0_prologue(F); } SEAM(0);
    for (int l = 0; l < DEPTH; ++l) {
        const int p = 1 + l * PH_PER_LAYER;
        if (IN(p)) {
            pg8::Gemm g{F.XB(), F.Win_t() + (size_t)l * NP * D, M, NP, D}; pg8::StaticOrder S; S.init(M, NP, F.G, (int)blockIdx.x);
            pg8::EpiProj E{F.PROJ(), NP, F.RSTD(), (const float*)F.ROPE()};
            pg8::gemm_phase<pg8::EpiProj, pg8::StaticOrder, true, true>(F.lds, g, S, E);
        } SEAM(p);
        if (IN(p + 1)) {
#if MK_SWA_MFMA
            swa_mfma(F, l);
#else
            swa_naive(F, l);
#endif
#if MK_SGU_MFMA
            sgu_mfma(F, l);
#else
            sgu_naive(F, l);
#endif
#if MK_GLA_MFMA
            gla_summ_mfma(F, l);
#else
            gla_summ_naive(F, l);
#endif
        } SEAM(p + 1);
        if (IN(p + 2)) {
#if MK_GLA_MFMA
            gla_out_mfma(F, l);
#else
            gla_out_naive(F, l);
#endif
        } SEAM(p + 2);
        if (IN(p + 3)) {
            pg8::Gemm g{F.YMIX(), F.Wout_t() + (size_t)l * D * D, M, D, D}; pg8::StaticOrder S; S.init(M, D, F.G, (int)blockIdx.x);
            pg8::EpiY E{F.Y(), D, F.SSQP()};
            pg8::gemm_phase<pg8::EpiY, pg8::StaticOrder, false, true>(F.lds, g, S, E);
        } SEAM(p + 3);
        if (IN(p + 4)) { resid_rows(F, l); } SEAM(p + 4);
    }
#undef IN
#undef SEAM
}

extern "C" void kernel_launch(void* const* d_in, const int* in_sizes, int n_in, void* d_out, int out_size, void* d_ws, size_t ws_size, hipStream_t stream) {
    static int grid = 0;
    if (grid == 0) {
        if (n_in != 14 || in_sizes[0] != M * D || out_size != M * D || ws_size < WS_END) { fprintf(stderr, "kernel_launch: unexpected shapes (n_in %d, in0 %d, out %d, ws %zu); nothing launched\n", n_in, n_in > 0 ? in_sizes[0] : -1, out_size, ws_size); grid = -1; return; }
        int dev = 0, cus = 0, per_cu = 0;
        if (hipGetDevice(&dev) != hipSuccess || hipDeviceGetAttribute(&cus, hipDeviceAttributeMultiprocessorCount, dev) != hipSuccess) { grid = -1; return; }
        if (hipFuncSetAttribute((const void*)hybrid_fwd, hipFuncAttributeMaxDynamicSharedMemorySize, LDS_BYTES) != hipSuccess) { fprintf(stderr, "kernel_launch: hipFuncSetAttribute failed\n"); grid = -1; return; }
        if (hipOccupancyMaxActiveBlocksPerMultiprocessor(&per_cu, (const void*)hybrid_fwd, NWAVES * 64, LDS_BYTES) != hipSuccess || per_cu < 1) { fprintf(stderr, "kernel_launch: occupancy query says %d blocks per CU; nothing launched\n", per_cu); (void)hipGetLastError(); grid = -1; return; }
        grid = cus;
        if (grid > 256) grid = 256;
    }
    if (grid < 0) return;
    (void)hipMemsetAsync((char*)d_ws + WS_CTL, 0, CTL_ZERO_BYTES, stream);
    Args a{};
    for (int i = 0; i < 14; ++i) a.in[i] = d_in[i];
    a.out = (float*)d_out; a.ws = (unsigned char*)d_ws;
#if MK_ONE_LAUNCH
    a.ph_lo = 0; a.ph_hi = N_PHASES;
    hipLaunchKernelGGL(hybrid_fwd, dim3(grid), dim3(NWAVES * 64), LDS_BYTES, stream, a);
#else
    for (int p = 0; p < N_PHASES; ++p) { a.ph_lo = p; a.ph_hi = p + 1; hipLaunchKernelGGL(hybrid_fwd, dim3(grid), dim3(NWAVES * 64), LDS_BYTES, stream, a); }
#endif
}
```
